# Optimizing an MI355X kernel written in HIP

```python
import math
import jax, jax.numpy as jnp
from jax import lax
import numpy as np

D_MODEL = 1024
BATCH = 2
SEQ = 8192
DEPTH = 4

A_HEADS = 6
A_HEAD_DIM = 64
A_CONFIGS = ((128, 1), (512, 4), (2048, 16))
B_HEADS = 4
B_QK_DIM = 64
B_V_DIM = 2 * B_QK_DIM
C_HEADS = 6
C_NOPE_DIM = 64
C_ROPE_DIM = 32
C_V_DIM = 64
C_Q_RANK = 256
C_KV_RANK = 128
ROPE_BASE = 10000.0
N_BUCKETS = 32
MAX_DISTANCE = 2048
BIAS_HEADS = A_HEADS + B_HEADS
PEER_HEADS = 8
PEER_KEYS = 128
PEER_EXPERTS = PEER_KEYS * PEER_KEYS
PEER_KEY_DIM = 128
PEER_TOPK = 16
PEER_CHUNK = 128
Q_BLOCK = 128
RMS_EPS = 1e-6
NEG_INF = -1e30

A_COLS = 3 * A_HEADS * A_HEAD_DIM
B_QK_COLS = B_HEADS * 2 * B_QK_DIM
B_V_COLS = B_HEADS * B_V_DIM
C_COLS = C_Q_RANK + C_KV_RANK + C_ROPE_DIM
GATE_COLS = 3 * D_MODEL
IN_COLS = A_COLS + 2 * B_QK_COLS + B_V_COLS + C_COLS + GATE_COLS
A_WIDTH = A_HEADS * A_HEAD_DIM
B_WIDTH = B_HEADS * B_V_DIM
C_WIDTH = C_HEADS * C_V_DIM

kernel_name = "hybrid_gated_dilated_diff_mla_peer"


def rmsnorm(x, g):
    xf = x.astype(jnp.float32)
    y = xf * lax.rsqrt(jnp.mean(xf * xf, axis=-1, keepdims=True) + RMS_EPS)
    return (y * g.astype(jnp.float32)).astype(x.dtype)


def t5_bucket(dist):
    n = jnp.maximum(dist, 0)
    max_exact = N_BUCKETS // 2
    nf = jnp.maximum(n, max_exact).astype(jnp.float32)
    large = max_exact + (jnp.log(nf / max_exact) / math.log(MAX_DISTANCE / max_exact)
                         * (N_BUCKETS - max_exact)).astype(jnp.int32)
    large = jnp.minimum(large, N_BUCKETS - 1)
    return jnp.where(n < max_exact, n, large)


def rope_tables(seq_len):
    half = C_ROPE_DIM // 2
    inv = ROPE_BASE ** (-jnp.arange(half, dtype=jnp.float32) / half)
    ang = jnp.arange(seq_len, dtype=jnp.float32)[:, None] * inv[None, :]
    return jnp.cos(ang), jnp.sin(ang)


def apply_rope(x, cos, sin):
    x1, x2 = jnp.split(x, 2, axis=-1)
    c = cos.astype(x.dtype)
    s = sin.astype(x.dtype)
    return jnp.concatenate([x1 * c - x2 * s, x1 * s + x2 * c], axis=-1)


def strided_window_attention(q, k, v, bias_table, window, dilation):
    bsz, seq, heads, dh = q.shape
    w = window // dilation
    span = w * dilation
    sp = -(-seq // span) * span
    pad = sp - seq
    nb = sp // span

    def to_blocks(t):
        t = jnp.pad(t, ((0, 0), (0, pad), (0, 0), (0, 0)))
        t = t.reshape(bsz, sp // dilation, dilation, heads, dh)
        t = t.transpose(0, 2, 1, 3, 4)
        return t.reshape(bsz, dilation, nb, w, heads, dh)

    def with_prev(t):
        prev = jnp.pad(t[:, :, :-1], ((0, 0), (0, 0), (1, 0), (0, 0), (0, 0), (0, 0)))
        return jnp.concatenate([prev, t], axis=3)

    qb = to_blocks(q)
    kk = with_prev(to_blocks(k))
    vv = with_prev(to_blocks(v))
    logits = jnp.einsum('brnqhd,brnkhd->brnhqk', qb, kk).astype(jnp.float32) / math.sqrt(dh)
    qi = jnp.arange(w)[:, None]
    ki = jnp.arange(2 * w)[None, :]
    rel = w + qi - ki
    band = (rel >= 0) & (rel <= w)
    bias = bias_table[t5_bucket(rel * dilation)].astype(jnp.float32)
    logits = logits + bias.transpose(2, 0, 1)
    first = (jnp.arange(nb)[:, None, None] == 0) & (ki[None] < w)
    valid = band[None] & ~first
    logits = jnp.where(valid[None, None, :, None], logits, NEG_INF)
    lse = jax.nn.logsumexp(logits, axis=-1)
    p = jnp.exp(logits - lse[..., None]).astype(v.dtype)
    out = jnp.einsum('brnhqk,brnkhd->brnqhd', p, vv)
    out = out.reshape(bsz, dilation, sp // dilation, heads, dh).transpose(0, 2, 1, 3, 4)
    out = out.reshape(bsz, sp, heads, dh)[:, :seq]
    lse = lse.transpose(0, 1, 2, 4, 3).reshape(bsz, dilation, sp // dilation, heads)
    lse = lse.transpose(0, 2, 1, 3).reshape(bsz, sp, heads)[:, :seq]
    return out, lse


def dilated_attention(q, k, v, bias_table):
    outs, lses = [], []
    for window, dilation in A_CONFIGS:
        o, l = strided_window_attention(q, k, v, bias_table, window, dilation)
        outs.append(o)
        lses.append(l)
    wts = jax.nn.softmax(jnp.stack(lses, 0), axis=0)
    return jnp.einsum('gbsh,gbshd->bshd', wts.astype(q.dtype), jnp.stack(outs, 0))


def to_qblocks(t):
    bsz, heads, seq, dd = t.shape
    return t.reshape(bsz, heads, seq // Q_BLOCK, Q_BLOCK, dd).transpose(2, 0, 1, 3, 4)


def from_qblocks(out):
    nb, bsz, heads, qb, dd = out.shape
    return out.transpose(1, 0, 3, 2, 4).reshape(bsz, nb * qb, heads, dd)


def diff_attention(q1, q2, k1, k2, v, bias_table, lam, lam_init, subln_g):
    bsz, heads, seq, d = q1.shape
    nb = seq // Q_BLOCK
    scale = 1.0 / math.sqrt(d)
    kpos = jnp.arange(seq)

    def body(args):
        i, qa, qb = args
        qpos = i * Q_BLOCK + jnp.arange(Q_BLOCK)
        dist = qpos[:, None] - kpos[None, :]
        causal = dist >= 0
        bias = bias_table[t5_bucket(dist)].astype(jnp.float32).transpose(2, 0, 1)

        def probs(qx, kx):
            s = jnp.einsum('bhqd,bhkd->bhqk', qx, kx).astype(jnp.float32) * scale + bias
            return jax.nn.softmax(jnp.where(causal, s, NEG_INF), axis=-1)

        a = probs(qa, k1) - lam * probs(qb, k2)
        return jnp.einsum('bhqk,bhkd->bhqd', a.astype(v.dtype), v)

    out = lax.map(body, (jnp.arange(nb), to_qblocks(q1), to_qblocks(q2)))
    out = from_qblocks(out)
    out = rmsnorm(out, subln_g) * (1.0 - lam_init)
    return out.reshape(bsz, seq, heads * 2 * d)


def mla_attention(q_nope, q_rope, k_nope, k_rope, v):
    bsz, heads, seq, _ = q_nope.shape
    nb = seq // Q_BLOCK
    scale = 1.0 / math.sqrt(C_NOPE_DIM + C_ROPE_DIM)
    kpos = jnp.arange(seq)

    def body(args):
        i, qn, qr = args
        qpos = i * Q_BLOCK + jnp.arange(Q_BLOCK)
        causal = (qpos[:, None] - kpos[None, :]) >= 0
        s = (jnp.einsum('bhqd,bhkd->bhqk', qn, k_nope)
             + jnp.einsum('bhqd,bkd->bhqk', qr, k_rope)).astype(jnp.float32) * scale
        p = jax.nn.softmax(jnp.where(causal, s, NEG_INF), axis=-1)
        return jnp.einsum('bhqk,bhkd->bhqd', p.astype(v.dtype), v)

    out = lax.map(body, (jnp.arange(nb), to_qblocks(q_nope), to_qblocks(q_rope)))
    return from_qblocks(out).reshape(bsz, seq, heads * C_V_DIM)


def peer_ffn(h, w_q, sub_keys, u, v_e):
    bsz, seq, d = h.shape
    q = (h @ w_q).reshape(bsz, seq, PEER_HEADS, 2, PEER_KEY_DIM // 2)
    scores = jnp.einsum('bshpd,hpkd->bshpk', q, sub_keys).astype(jnp.float32)
    top_s, top_i = lax.top_k(scores, PEER_TOPK)
    cand = top_s[..., 0, :, None] + top_s[..., 1, None, :]
    best_s, best_c = lax.top_k(cand.reshape(bsz, seq, PEER_HEADS, PEER_TOPK * PEER_TOPK), PEER_TOPK)
    i1 = jnp.take_along_axis(top_i[..., 0, :], best_c // PEER_TOPK, axis=-1)
    i2 = jnp.take_along_axis(top_i[..., 1, :], best_c % PEER_TOPK, axis=-1)
    idx = i1 * PEER_KEYS + i2
    gate = jax.nn.softmax(best_s, axis=-1).astype(h.dtype)
    n_chunks = (bsz * seq) // PEER_CHUNK
    idx = idx.reshape(n_chunks, PEER_CHUNK, PEER_HEADS * PEER_TOPK)
    gate = gate.reshape(n_chunks, PEER_CHUNK, PEER_HEADS * PEER_TOPK)
    hc = h.reshape(n_chunks, PEER_CHUNK, d)

    def body(args):
        ic, gc, xc = args
        act = jax.nn.gelu(jnp.einsum('tkd,td->tk', u[ic], xc), approximate=False)
        return jnp.einsum('tk,tkd->td', gc * act, v_e[ic])

    out = lax.map(body, (idx, gate, hc))
    return out.reshape(bsz, seq, d)


def split_in_proj(proj):
    sizes = [A_COLS, B_QK_COLS, B_QK_COLS, B_V_COLS, C_Q_RANK, C_KV_RANK, C_ROPE_DIM]
    bounds, acc = [], 0
    for s in sizes:
        acc += s
        bounds.append(acc)
    return jnp.split(proj, bounds, axis=-1)


def setup_inputs(seed: int = 0) -> dict:
    key = jax.random.key(seed)
    ks = jax.random.split(key, 24)
    f32 = jnp.float32

    def nrm(k, shape, scale):
        return jax.random.normal(k, shape, f32) * scale

    def gain(k, shape):
        return 1.0 + 0.02 * jax.random.normal(k, shape, f32)

    L, D = DEPTH, D_MODEL
    return {
        "x": nrm(ks[0], (BATCH, SEQ, D), 1.0),
        "rel_bias": nrm(ks[1], (N_BUCKETS, BIAS_HEADS), 0.5),
        "w_in": nrm(ks[2], (L, D, IN_COLS), D ** -0.5),
        "g_mix": gain(ks[3], (L, D)),
        "w_uq": nrm(ks[4], (L, C_Q_RANK, C_HEADS * (C_NOPE_DIM + C_ROPE_DIM)), C_Q_RANK ** -0.5),
        "g_cq": gain(ks[5], (L, C_Q_RANK)),
        "w_ukv": nrm(ks[6], (L, C_KV_RANK, C_HEADS * (C_NOPE_DIM + C_V_DIM)), C_KV_RANK ** -0.5),
        "g_ckv": gain(ks[7], (L, C_KV_RANK)),
        "lam_q1": nrm(ks[8], (L, B_QK_DIM), 0.1),
        "lam_k1": nrm(ks[9], (L, B_QK_DIM), 0.1),
        "lam_q2": nrm(ks[10], (L, B_QK_DIM), 0.1),
        "lam_k2": nrm(ks[11], (L, B_QK_DIM), 0.1),
        "g_subln": gain(ks[12], (L, B_V_DIM)),
        "w_branch_a": nrm(ks[13], (L, A_WIDTH, D), A_WIDTH ** -0.5),
        "w_branch_b": nrm(ks[14], (L, B_WIDTH, D), B_WIDTH ** -0.5),
        "w_branch_c": nrm(ks[15], (L, C_WIDTH, D), C_WIDTH ** -0.5),
        "w_out": nrm(ks[16], (L, D, D), D ** -0.5),
        "g_ffn": gain(ks[17], (L, D)),
        "w_peer_q": nrm(ks[18], (L, D, PEER_HEADS * PEER_KEY_DIM), D ** -0.5),
        "peer_sub_keys": nrm(ks[19], (L, PEER_HEADS, 2, PEER_KEYS, PEER_KEY_DIM // 2), (PEER_KEY_DIM // 2) ** -0.5),
        "peer_u": nrm(ks[20], (L, PEER_EXPERTS, D), D ** -0.5),
        "peer_v": nrm(ks[21], (L, PEER_EXPERTS, D), (PEER_HEADS * PEER_TOPK) ** -0.5),
        "g_final": gain(ks[22], (D,)),
    }


def reference(x, rel_bias, w_in, g_mix, w_uq, g_cq, w_ukv, g_ckv, lam_q1, lam_k1, lam_q2, lam_k2,
              g_subln, w_branch_a, w_branch_b, w_branch_c, w_out, g_ffn, w_peer_q, peer_sub_keys,
              peer_u, peer_v, g_final):
    bsz, seq, d = x.shape
    cos, sin = rope_tables(seq)
    bias_a = rel_bias[:, :A_HEADS]
    bias_b = rel_bias[:, A_HEADS:]
    for l in range(DEPTH):
        h = rmsnorm(x, g_mix[l])
        proj = h @ w_in[l]
        a_qkv, b_q, b_k, b_v, c_q, c_kv, c_kr, gates = split_in_proj(proj)

        a = a_qkv.reshape(bsz, seq, 3, A_HEADS, A_HEAD_DIM)
        y_a = dilated_attention(a[:, :, 0], a[:, :, 1], a[:, :, 2], bias_a).reshape(bsz, seq, A_WIDTH)

        bq = b_q.reshape(bsz, seq, B_HEADS, 2, B_QK_DIM).transpose(3, 0, 2, 1, 4)
        bk = b_k.reshape(bsz, seq, B_HEADS, 2, B_QK_DIM).transpose(3, 0, 2, 1, 4)
        bv = b_v.reshape(bsz, seq, B_HEADS, B_V_DIM).transpose(0, 2, 1, 3)
        lam_init = 0.8 - 0.6 * math.exp(-0.3 * l)
        lam = (jnp.exp(jnp.sum(lam_q1[l].astype(jnp.float32) * lam_k1[l].astype(jnp.float32)))
               - jnp.exp(jnp.sum(lam_q2[l].astype(jnp.float32) * lam_k2[l].astype(jnp.float32)))
               + lam_init)
        y_b = diff_attention(bq[0], bq[1], bk[0], bk[1], bv, bias_b, lam, lam_init, g_subln[l])

        cq = (rmsnorm(c_q, g_cq[l]) @ w_uq[l]).reshape(bsz, seq, C_HEADS, C_NOPE_DIM + C_ROPE_DIM)
        q_nope, q_rope = cq[..., :C_NOPE_DIM], cq[..., C_NOPE_DIM:]
        q_rope = apply_rope(q_rope, cos[:, None, :], sin[:, None, :])
        ckv = (rmsnorm(c_kv, g_ckv[l]) @ w_ukv[l]).reshape(bsz, seq, C_HEADS, C_NOPE_DIM + C_V_DIM)
        k_nope, v_c = ckv[..., :C_NOPE_DIM], ckv[..., C_NOPE_DIM:]
        k_rope = apply_rope(c_kr, cos, sin)
        y_c = mla_attention(q_nope.transpose(0, 2, 1, 3), q_rope.transpose(0, 2, 1, 3),
                            k_nope.transpose(0, 2, 1, 3), k_rope, v_c.transpose(0, 2, 1, 3))

        g = jax.nn.sigmoid(gates.reshape(bsz, seq, 3, d))
        mix = (g[:, :, 0] * (y_a @ w_branch_a[l])
               + g[:, :, 1] * (y_b @ w_branch_b[l])
               + g[:, :, 2] * (y_c @ w_branch_c[l]))
        x = x + mix @ w_out[l]

        h2 = rmsnorm(x, g_ffn[l])
        x = x + peer_ffn(h2, w_peer_q[l], peer_sub_keys[l], peer_u[l], peer_v[l])
    return rmsnorm(x, g_final)
```

```cpp
#include <hip/hip_runtime.h>
#include <hip/hip_cooperative_groups.h>
#include <cstdio>
#include <cstdint>
#include <cmath>
#include <cstring>
namespace cg = cooperative_groups;

typedef unsigned short bf16_t;
typedef short bf16x8 __attribute__((ext_vector_type(8)));
typedef float f32x4 __attribute__((ext_vector_type(4)));
typedef unsigned u32x4 __attribute__((ext_vector_type(4)));
typedef unsigned u32x2 __attribute__((ext_vector_type(2)));

constexpr int T_TOK = 16384, SEQ = 8192, DM = 1024, NLAYER = 4;
constexpr int INC = 6272;
constexpr int NTHREADS = 256;
constexpr int SMEM_BYTES = 67712 + 16;
constexpr float LOG2E = 1.4426950408889634f;
constexpr float LN2 = 0.6931471805599453f;

struct TrJob { const float* src; const float* g; bf16_t* dst; int K, N, lds, ldd, tile0, ntn; };

struct Params {
  const float *x, *rel_bias, *lam_q1, *lam_k1, *lam_q2, *lam_k2, *g_subln, *peer_u, *peer_v, *sub_keys, *g_final, *g_ffn;
  float* out;
  float* xcur; bf16_t* xb; bf16_t* qkvA; bf16_t* qkB; bf16_t* vtB; bf16_t* cq_lat; bf16_t* ckv_lat; float* ssq_cq; float* ssq_ckv;
  bf16_t* gates; bf16_t* cq; bf16_t* kC; bf16_t* vtC; bf16_t* oA; bf16_t* oB; float* lseA; bf16_t* y; bf16_t* mix; float* ssq2; bf16_t* pq;
  int* pidx; float* pgate; float* pw; float* ssqn;
  bf16_t *Wt_in, *Wt_uq, *Wt_ukv, *Wt_br, *Wt_out, *Wt_pq, *skeys; unsigned char *pu8, *pv8;
  float *biasA2, *biasB2, *ropec, *ropes, *lam; int* counters; unsigned* bar;
  TrJob jobs[44]; int njobs; int total_tr_tiles;
};

__device__ __forceinline__ unsigned pack2(float lo, float hi) { unsigned r; asm("v_cvt_pk_bf16_f32 %0, %1, %2" : "=v"(r) : "v"(lo), "v"(hi)); return r; }
__device__ __forceinline__ float bflo(unsigned u) { return __uint_as_float(u << 16); }
__device__ __forceinline__ float bfhi(unsigned u) { return __uint_as_float(u & 0xffff0000u); }
__device__ __forceinline__ f32x4 mfma16(bf16x8 a, bf16x8 b, f32x4 c) { return __builtin_amdgcn_mfma_f32_16x16x32_bf16(a, b, c, 0, 0, 0); }
__device__ __forceinline__ float fexp2(float x) { return __builtin_amdgcn_exp2f(x); }
__device__ __forceinline__ int opaque_tid() { int t = threadIdx.x; asm volatile("" : "+v"(t)); return t; }
__device__ __forceinline__ float fmax3(float a, float b, float c) { float r; asm("v_max3_f32 %0, %1, %2, %3" : "=v"(r) : "v"(a), "v"(b), "v"(c)); return r; }
__device__ __forceinline__ unsigned xswap16_max_u(unsigned x) { auto r = __builtin_amdgcn_permlane16_swap(x, x, false, false); return max(r[0], r[1]); }
__device__ __forceinline__ unsigned xswap32_max_u(unsigned x) { auto r = __builtin_amdgcn_permlane32_swap(x, x, false, false); return max(r[0], r[1]); }
__device__ __forceinline__ float xmax_rows(float x) {
  auto r = __builtin_amdgcn_permlane16_swap(__float_as_uint(x), __float_as_uint(x), false, false);
  const float m = fmax3(__uint_as_float(r[0]), __uint_as_float(r[1]), __uint_as_float(r[1]));
  auto q = __builtin_amdgcn_permlane32_swap(__float_as_uint(m), __float_as_uint(m), false, false);
  return fmax3(__uint_as_float(q[0]), __uint_as_float(q[1]), __uint_as_float(q[1]));
}
__device__ __forceinline__ float xsum_rows(float x) {
  auto r = __builtin_amdgcn_permlane16_swap(__float_as_uint(x), __float_as_uint(x), false, false);
  const float m = __uint_as_float(r[0]) + __uint_as_float(r[1]);
  auto q = __builtin_amdgcn_permlane32_swap(__float_as_uint(m), __float_as_uint(m), false, false);
  return __uint_as_float(q[0]) + __uint_as_float(q[1]);
}
__device__ __forceinline__ void lds_barrier() { asm volatile("s_waitcnt lgkmcnt(0)\n\ts_barrier" ::: "memory"); }
__device__ __forceinline__ float wave_sum(float v) {
#pragma unroll
  for (int o = 32; o > 0; o >>= 1) v += __shfl_xor(v, o);
  return v;
}

constexpr int GS = 64, GSTAGE = 128 * GS;
template <bool PF2>
__device__ __forceinline__ void gemm_mainloop_t(const bf16_t* __restrict__ A, int lda, const bf16_t* __restrict__ Bt, int ldb, int K,
                                                bf16_t* smem, f32x4 (&acc)[4][4], const int tid) {
  const int lane = tid & 63, w = tid >> 6, wm = w >> 1, wn = w & 1, fr = lane & 15, fq = lane >> 4;
  const int lr = tid >> 3, lc = (tid & 7) * 8, lcs = ((tid & 7) ^ (lr & 7)) * 8;
  const bf16_t* ag = A + (size_t)lr * lda + lc;
  const bf16_t* bg = Bt + (size_t)lr * ldb + lc;
  u32x4 ra[PF2 ? 2 : 1][4], rb[PF2 ? 2 : 1][4];
  const int nk = K >> 6;
  auto gload = [&](int set, int kt) {
    const int k0 = kt << 6;
#pragma unroll
    for (int i = 0; i < 4; ++i) { ra[set][i] = *(const u32x4*)(ag + (size_t)(32 * i) * lda + k0); rb[set][i] = *(const u32x4*)(bg + (size_t)(32 * i) * ldb + k0); }
  };
  auto sstore = [&](int set, int st) {
    bf16_t* ds = smem + st * 2 * GSTAGE;
#pragma unroll
    for (int i = 0; i < 4; ++i) { *(u32x4*)(ds + (lr + 32 * i) * GS + lcs) = ra[set][i]; *(u32x4*)(ds + GSTAGE + (lr + 32 * i) * GS + lcs) = rb[set][i]; }
  };
  auto compute = [&](int st) {
    const bf16_t* as = smem + st * 2 * GSTAGE;
    const bf16_t* bs = as + GSTAGE;
#pragma unroll
    for (int ks = 0; ks < 2; ++ks) {
      bf16x8 af[4], bfr[4];
#pragma unroll
      for (int mi = 0; mi < 4; ++mi) af[mi] = *(const bf16x8*)(as + (wm * 64 + mi * 16 + fr) * GS + (((ks * 4 + fq) ^ (fr & 7)) * 8));
#pragma unroll
      for (int ni = 0; ni < 4; ++ni) bfr[ni] = *(const bf16x8*)(bs + (wn * 64 + ni * 16 + fr) * GS + (((ks * 4 + fq) ^ (fr & 7)) * 8));
#pragma unroll
      for (int mi = 0; mi < 4; ++mi)
#pragma unroll
        for (int ni = 0; ni < 4; ++ni) acc[mi][ni] = mfma16(bfr[ni], af[mi], acc[mi][ni]);
    }
  };
  if (PF2) {
    gload(0, 0);
    gload(1, 1);
    sstore(0, 0);
    lds_barrier();
    for (int kt = 0; kt < nk; kt += 2) {
      gload(0, min(kt + 2, nk - 1));
      __builtin_amdgcn_sched_barrier(0);
      compute(0);
      sstore(1, 1);
      lds_barrier();
      gload(1, min(kt + 3, nk - 1));
      __builtin_amdgcn_sched_barrier(0);
      compute(1);
      sstore(0, 0);
      lds_barrier();
    }
  } else {
    gload(0, 0); sstore(0, 0);
    lds_barrier();
    for (int kt = 0; kt < nk; ++kt) {
      gload(0, min(kt + 1, nk - 1));
      __builtin_amdgcn_sched_barrier(0);
      compute(kt & 1);
      __builtin_amdgcn_sched_barrier(0);
      sstore(0, (kt + 1) & 1);
      lds_barrier();
    }
  }
}
#ifndef GEMM_PF2
#define GEMM_PF2 true
#endif
__device__ __forceinline__ void gemm_mainloop(const bf16_t* __restrict__ A, int lda, const bf16_t* __restrict__ Bt, int ldb, int K,
                                              bf16_t* smem, f32x4 (&acc)[4][4], const int tid) {
  gemm_mainloop_t<GEMM_PF2>(A, lda, Bt, ldb, K, smem, acc, tid);
}

__device__ __forceinline__ void zero_acc(f32x4 (&acc)[4][4]) {
#pragma unroll
  for (int i = 0; i < 4; ++i)
#pragma unroll
    for (int j = 0; j < 4; ++j) acc[i][j] = (f32x4){0.f, 0.f, 0.f, 0.f};
}

__device__ __forceinline__ bool xcd_tile(int iter, int MT, int NT, int& m, int& n) {
  const int xcd = blockIdx.x & 7, slot = blockIdx.x >> 3, per = gridDim.x >> 3;
  const int mper = MT >> 3;
  const int li = iter * per + slot;
  if (li >= mper * NT) return false;
  const int mg = li / (NT * 8), rem = li % (NT * 8);
  n = rem >> 3;
  int mi = (rem & 7) + mg * 8;
  m = xcd * mper + mi;
  return true;
}

__device__ __forceinline__ void store4bf(bf16_t* p, f32x4 v) { u32x2 o; o.x = pack2(v[0], v[1]); o.y = pack2(v[2], v[3]); *(u32x2*)p = o; }

__device__ __forceinline__ void peer_convert_chunk(const Params& p, int l, size_t i) {
  const size_t base = (size_t)l * 16384 * 1024 + i * 16;
  u32x4 ou, ov;
#pragma unroll
  for (int c = 0; c < 4; ++c) {
    const f32x4 a = *(const f32x4*)(p.peer_u + base + c * 4) * 256.f;
    int r = 0; r = __builtin_amdgcn_cvt_pk_fp8_f32(a[0], a[1], r, false); r = __builtin_amdgcn_cvt_pk_fp8_f32(a[2], a[3], r, true); ou[c] = (unsigned)r;
    const f32x4 d = *(const f32x4*)(p.peer_v + base + c * 4) * 64.f;
    int q = 0; q = __builtin_amdgcn_cvt_pk_fp8_f32(d[0], d[1], q, false); q = __builtin_amdgcn_cvt_pk_fp8_f32(d[2], d[3], q, true); ov[c] = (unsigned)q;
  }
  *(u32x4*)(p.pu8 + base) = ou;
  *(u32x4*)(p.pv8 + base) = ov;
}

__device__ void phase_inproj(const Params& p, int l, unsigned char* smem) {
  const int tid = opaque_tid(), lane = tid & 63, w = tid >> 6, wm = w >> 1, wn = w & 1, fr = lane & 15, fq = lane >> 4;
  const bf16_t* W = p.Wt_in + (size_t)l * INC * DM;
  int mt, ct;
  constexpr size_t N16L = (size_t)16384 * 1024 / 16;
  int it = 0;
  for (; xcd_tile(it, 128, 49, mt, ct); ++it) {
    f32x4 acc[4][4]; zero_acc(acc);
    gemm_mainloop(p.xb + (size_t)mt * 128 * DM, DM, W + (size_t)ct * 128 * DM, DM, DM, (bf16_t*)smem, acc, tid);
    const int rowb = mt * 128 + wm * 64 + fr;
    const int colb = ct * 128 + wn * 64 + fq * 4;
#pragma unroll
    for (int mi = 0; mi < 4; ++mi) {
      const f32x4 s0 = *(const f32x4*)(p.ssqn + (rowb + mi * 16) * 8), s1 = *(const f32x4*)(p.ssqn + (rowb + mi * 16) * 8 + 4);
      const float rstd = rsqrtf(((s0[0] + s0[1]) + (s0[2] + s0[3]) + (s1[0] + s1[1]) + (s1[2] + s1[3])) * (1.f / 1024.f) + 1e-6f);
#pragma unroll
      for (int ni = 0; ni < 4; ++ni) acc[mi][ni] *= rstd;
    }
    if (ct < 9) {
#pragma unroll
      for (int mi = 0; mi < 4; ++mi)
#pragma unroll
        for (int ni = 0; ni < 4; ++ni) store4bf(p.qkvA + (size_t)(rowb + mi * 16) * 1152 + colb + ni * 16, acc[mi][ni]);
    } else if (ct < 17) {
#pragma unroll
      for (int mi = 0; mi < 4; ++mi)
#pragma unroll
        for (int ni = 0; ni < 4; ++ni) store4bf(p.qkB + (size_t)(rowb + mi * 16) * 1024 + (colb - 1152) + ni * 16, acc[mi][ni]);
    } else if (ct < 21) {
      const int h = ct - 17;
#pragma unroll
      for (int mi = 0; mi < 4; ++mi) {
        const int row = rowb + mi * 16, b = row >> 13, pos = row & 8191;
#pragma unroll
        for (int ni = 0; ni < 4; ++ni) {
          const int dv = wn * 64 + ni * 16 + fq * 4;
          bf16_t* d = p.vtB + ((size_t)((b * 4 + h) * 128 + dv)) * SEQ + pos;
          const unsigned u0 = pack2(acc[mi][ni][0], acc[mi][ni][1]), u1 = pack2(acc[mi][ni][2], acc[mi][ni][3]);
          d[0] = (bf16_t)u0; d[SEQ] = (bf16_t)(u0 >> 16); d[2 * SEQ] = (bf16_t)u1; d[3 * SEQ] = (bf16_t)(u1 >> 16);
        }
      }
    } else if (ct < 24) {
#pragma unroll
      for (int mi = 0; mi < 4; ++mi) {
        const int row = rowb + mi * 16;
        float s = 0.f;
#pragma unroll
        for (int ni = 0; ni < 4; ++ni) {
          const f32x4 v = acc[mi][ni];
          s += v[0] * v[0] + v[1] * v[1] + v[2] * v[2] + v[3] * v[3];
          if (ct < 23) store4bf(p.cq_lat + (size_t)row * 256 + (colb - 2688) + ni * 16, v);
          else store4bf(p.ckv_lat + (size_t)row * 128 + (colb - 2944) + ni * 16, v);
        }
        s = xsum_rows(s);
        if (fq == 0) { if (ct < 23) p.ssq_cq[row * 4 + (ct - 21) * 2 + wn] = s; else p.ssq_ckv[row * 2 + wn] = s; }
      }
    } else if (ct < 48) {
#pragma unroll
      for (int mi = 0; mi < 4; ++mi)
#pragma unroll
        for (int ni = 0; ni < 4; ++ni) {
          f32x4 v = acc[mi][ni];
#pragma unroll
          for (int r = 0; r < 4; ++r) v[r] = 1.f / (1.f + __expf(-v[r]));
          store4bf(p.gates + (size_t)(rowb + mi * 16) * 3072 + (colb - 3072) + ni * 16, v);
        }
    } else {
      if (wn == 0) {
#pragma unroll
        for (int mi = 0; mi < 4; ++mi) {
          const int row = rowb + mi * 16, pos = row & 8191;
          const f32x4 c = *(const f32x4*)(p.ropec + pos * 16 + fq * 4), s = *(const f32x4*)(p.ropes + pos * 16 + fq * 4);
          const f32x4 x1 = acc[mi][0], x2 = acc[mi][1];
          const f32x4 o1 = x1 * c - x2 * s, o2 = x1 * s + x2 * c;
#pragma unroll
          for (int h = 0; h < 6; ++h) {
            store4bf(p.kC + (size_t)row * 576 + h * 96 + 64 + fq * 4, o1);
            store4bf(p.kC + (size_t)row * 576 + h * 96 + 80 + fq * 4, o2);
          }
        }
      }
    }
    {
      const size_t ci = ((size_t)it * gridDim.x + blockIdx.x) * NTHREADS + tid;
      if (ci < N16L) peer_convert_chunk(p, l, ci);
    }
  }
  for (;; ++it) {
    const size_t ci = ((size_t)it * gridDim.x + blockIdx.x) * NTHREADS + tid;
    if ((size_t)it * gridDim.x * NTHREADS >= N16L) break;
    if (ci < N16L) peer_convert_chunk(p, l, ci);
  }
}

__device__ void phase_cup(const Params& p, int l, unsigned char* smem) {
  const int tid = opaque_tid(), lane = tid & 63, w = tid >> 6, wm = w >> 1, wn = w & 1, fr = lane & 15, fq = lane >> 4;
  int mt, ct;
  for (int it = 0; xcd_tile(it, 128, 11, mt, ct); ++it) {
    f32x4 acc[4][4]; zero_acc(acc);
    const int rowb = mt * 128 + wm * 64 + fr;
    if (ct < 5) {
      gemm_mainloop(p.cq_lat + (size_t)mt * 128 * 256, 256, p.Wt_uq + ((size_t)l * 640 + ct * 128) * 256, 256, 256, (bf16_t*)smem, acc, tid);
      const int c0 = ct * 128 + wn * 64;
#pragma unroll
      for (int mi = 0; mi < 4; ++mi) {
        const int row = rowb + mi * 16, pos = row & 8191;
        const f32x4 sq = *(const f32x4*)(p.ssq_cq + row * 4);
        const float rstd = rsqrtf((sq[0] + sq[1] + sq[2] + sq[3]) * (1.f / 256.f) + 1e-6f);
#pragma unroll
        for (int ni = 0; ni < 4; ++ni) {
          const int t16 = (c0 >> 4) + ni, col = c0 + ni * 16 + fq * 4;
          if (t16 >= 36) continue;
          const int ph = t16 % 6;
          if (ph < 4) store4bf(p.cq + (size_t)row * 576 + col, acc[mi][ni] * rstd);
          else if (ph == 4) {
            if (ni < 3) {
              const f32x4 c = *(const f32x4*)(p.ropec + pos * 16 + fq * 4), s = *(const f32x4*)(p.ropes + pos * 16 + fq * 4);
              const f32x4 x1 = acc[mi][ni] * rstd, x2 = acc[mi][ni + 1 > 3 ? 3 : ni + 1] * rstd;
              store4bf(p.cq + (size_t)row * 576 + col, x1 * c - x2 * s);
              store4bf(p.cq + (size_t)row * 576 + col + 16, x1 * s + x2 * c);
            }
          }
        }
      }
    } else {
      const int c2 = ct - 5;
      gemm_mainloop(p.ckv_lat + (size_t)mt * 128 * 128, 128, p.Wt_ukv + ((size_t)l * 768 + c2 * 128) * 128, 128, 128, (bf16_t*)smem, acc, tid);
      const int h = c2;
#pragma unroll
      for (int mi = 0; mi < 4; ++mi) {
        const int row = rowb + mi * 16, b = row >> 13, pos = row & 8191;
        const float rstd = rsqrtf((p.ssq_ckv[row * 2] + p.ssq_ckv[row * 2 + 1]) * (1.f / 128.f) + 1e-6f);
#pragma unroll
        for (int ni = 0; ni < 4; ++ni) {
          const f32x4 v = acc[mi][ni] * rstd;
          if (wn == 0) store4bf(p.kC + (size_t)row * 576 + h * 96 + ni * 16 + fq * 4, v);
          else {
            const int dv = ni * 16 + fq * 4;
            bf16_t* d = p.vtC + ((size_t)((b * 6 + h) * 64 + dv)) * SEQ + pos;
            const unsigned u0 = pack2(v[0], v[1]), u1 = pack2(v[2], v[3]);
            d[0] = (bf16_t)u0; d[SEQ] = (bf16_t)(u0 >> 16); d[2 * SEQ] = (bf16_t)u1; d[3 * SEQ] = (bf16_t)(u1 >> 16);
          }
        }
      }
    }
  }
}

__device__ void phase_branch(const Params& p, int l, unsigned char* smem) {
  const int tid = opaque_tid(), lane = tid & 63, w = tid >> 6, wm = w >> 1, wn = w & 1, fr = lane & 15, fq = lane >> 4;
  const bf16_t* W = p.Wt_br + (size_t)l * 1024 * 1280;
  int mt, ct;
  for (int it = 0; xcd_tile(it, 128, 8, mt, ct); ++it) {
    unsigned tot[4][4][2];
    const int rowb = mt * 128 + wm * 64 + fr, colb = ct * 128 + wn * 64 + fq * 4;
#pragma unroll 1
    for (int seg = 0; seg < 3; ++seg) {
      const int koff = seg == 0 ? 0 : (seg == 1 ? 384 : 896), kk = seg == 1 ? 512 : 384;
      f32x4 acc[4][4]; zero_acc(acc);
      gemm_mainloop_t<false>(p.y + (size_t)mt * 128 * 1280 + koff, 1280, W + (size_t)ct * 128 * 1280 + koff, 1280, kk, (bf16_t*)smem, acc, tid);
      u32x2 gg[4][4];
#pragma unroll
      for (int mi = 0; mi < 4; ++mi)
#pragma unroll
        for (int ni = 0; ni < 4; ++ni) gg[mi][ni] = *(const u32x2*)(p.gates + (size_t)(rowb + mi * 16) * 3072 + seg * 1024 + colb + ni * 16);
#pragma unroll
      for (int mi = 0; mi < 4; ++mi)
#pragma unroll
        for (int ni = 0; ni < 4; ++ni) {
          const u32x2 g = gg[mi][ni];
          float t0 = bflo(g.x) * acc[mi][ni][0], t1 = bfhi(g.x) * acc[mi][ni][1], t2 = bflo(g.y) * acc[mi][ni][2], t3 = bfhi(g.y) * acc[mi][ni][3];
          if (seg > 0) { t0 += bflo(tot[mi][ni][0]); t1 += bfhi(tot[mi][ni][0]); t2 += bflo(tot[mi][ni][1]); t3 += bfhi(tot[mi][ni][1]); }
          tot[mi][ni][0] = pack2(t0, t1); tot[mi][ni][1] = pack2(t2, t3);
        }
    }
#pragma unroll
    for (int mi = 0; mi < 4; ++mi)
#pragma unroll
      for (int ni = 0; ni < 4; ++ni) *(u32x2*)(p.mix + (size_t)(rowb + mi * 16) * 1024 + colb + ni * 16) = (u32x2){tot[mi][ni][0], tot[mi][ni][1]};
  }
}

__device__ void phase_wout(const Params& p, int l, unsigned char* smem) {
  const int tid = opaque_tid(), lane = tid & 63, w = tid >> 6, wm = w >> 1, wn = w & 1, fr = lane & 15, fq = lane >> 4;
  const bf16_t* W = p.Wt_out + (size_t)l * 1024 * 1024;
  int mt, ct;
  for (int it = 0; xcd_tile(it, 128, 8, mt, ct); ++it) {
    f32x4 acc[4][4]; zero_acc(acc);
    gemm_mainloop(p.mix + (size_t)mt * 128 * 1024, 1024, W + (size_t)ct * 128 * 1024, 1024, 1024, (bf16_t*)smem, acc, tid);
    const int rowb = mt * 128 + wm * 64 + fr, colb = ct * 128 + wn * 64 + fq * 4;
    f32x4 xin[4][4];
#pragma unroll
    for (int mi = 0; mi < 4; ++mi)
#pragma unroll
      for (int ni = 0; ni < 4; ++ni) xin[mi][ni] = *(const f32x4*)((l == 0 ? p.x : p.xcur) + (size_t)(rowb + mi * 16) * 1024 + colb + ni * 16);
#pragma unroll
    for (int mi = 0; mi < 4; ++mi) {
      const int row = rowb + mi * 16;
      float s = 0.f;
#pragma unroll
      for (int ni = 0; ni < 4; ++ni) {
        const f32x4 v = xin[mi][ni] + acc[mi][ni];
        *(f32x4*)(p.xcur + (size_t)row * 1024 + colb + ni * 16) = v;
        store4bf(p.xb + (size_t)row * 1024 + colb + ni * 16, v);
        s += v[0] * v[0] + v[1] * v[1] + v[2] * v[2] + v[3] * v[3];
      }
      s = xsum_rows(s);
      if (fq == 0) p.ssq2[row * 16 + ct * 2 + wn] = s;
    }
  }
}

__device__ void phase_pq(const Params& p, int l, unsigned char* smem) {
  const int tid = opaque_tid(), lane = tid & 63, w = tid >> 6, wm = w >> 1, wn = w & 1, fr = lane & 15, fq = lane >> 4;
  const bf16_t* W = p.Wt_pq + (size_t)l * 1024 * 1024;
  int mt, ct;
  for (int it = 0; xcd_tile(it, 128, 8, mt, ct); ++it) {
    f32x4 acc[4][4]; zero_acc(acc);
    gemm_mainloop(p.xb + (size_t)mt * 128 * 1024, 1024, W + (size_t)ct * 128 * 1024, 1024, 1024, (bf16_t*)smem, acc, tid);
    const int rowb = mt * 128 + wm * 64 + fr, colb = ct * 128 + wn * 64 + fq * 4;
    f32x4 sq[4][4];
#pragma unroll
    for (int mi = 0; mi < 4; ++mi)
#pragma unroll
      for (int i = 0; i < 4; ++i) sq[mi][i] = *(const f32x4*)(p.ssq2 + (rowb + mi * 16) * 16 + i * 4);
#pragma unroll
    for (int mi = 0; mi < 4; ++mi) {
      const int row = rowb + mi * 16;
      float s = 0.f;
#pragma unroll
      for (int i = 0; i < 4; ++i) s += sq[mi][i][0] + sq[mi][i][1] + sq[mi][i][2] + sq[mi][i][3];
      const float rstd = rsqrtf(s * (1.f / 1024.f) + 1e-6f);
#pragma unroll
      for (int ni = 0; ni < 4; ++ni) store4bf(p.pq + (size_t)row * 1024 + colb + ni * 16, acc[mi][ni] * rstd);
    }
  }
}

#ifndef ATT_SB
#define ATT_SB 1
#endif
#if ATT_SB
#define ATT_SCHED_BARRIER __builtin_amdgcn_sched_barrier(0)
#else
#define ATT_SCHED_BARRIER
#endif
#ifndef ATT_PVB
#define ATT_PVB 4
#endif
#ifndef ATT_QG_B
#define ATT_QG_B 2
#endif
constexpr int VTS = 80;
constexpr int ATT_K_OFF = 0, ATT_V_OFF = 14336, ATT_BIAS_OFF = 14336 + 20480, ATT_MISC_OFF = ATT_BIAS_OFF + 8192, ATT_Q_OFF = ATT_MISC_OFF + 64;

template <int DQK, int DV, int MODE>
__device__ __forceinline__ void flash_block(const bf16_t* __restrict__ Qp, int qrs, const bf16_t* __restrict__ Kp, int krs,
                                            const bf16_t* __restrict__ Vp, int vrs, int kt_begin, int kt_end, int qpos0, int jmin,
                                            float c1, unsigned char* smem, f32x4 (&O)[2][DV / 16], float (&mrow)[2], float (&lrow)[2], const int tid) {
  constexpr int KST = DQK + 16, KCH = DQK / 8, NKC = 64 * KCH / 256, NVC = (MODE == 0) ? 2 : DV * 8 / 256, NDT = DV / 16, NKS = DQK / 32;
  const int lane = tid & 63, w = tid >> 6, fr = lane & 15, fq = lane >> 4;
  bf16_t* Ks = (bf16_t*)(smem + ATT_K_OFF);
  bf16_t* Vt = (bf16_t*)(smem + ATT_V_OFF);
  const float* bias_lds = (const float*)(smem + ATT_BIAS_OFF);
  bf16_t* Qs = (bf16_t*)(smem + ATT_Q_OFF) + (w * 2 * NKS) * 512 + lane * 8;
#pragma unroll
  for (int qi = 0; qi < 2; ++qi)
#pragma unroll
    for (int ks = 0; ks < NKS; ++ks)
      *(bf16x8*)(Qs + (qi * NKS + ks) * 512) = *(const bf16x8*)(Qp + (unsigned)((w * 32 + qi * 16 + fr) * qrs + ks * 32 + fq * 8));
#pragma unroll
  for (int qi = 0; qi < 2; ++qi) {
    mrow[qi] = -1e30f; lrow[qi] = 0.f;
#pragma unroll
    for (int dt = 0; dt < NDT; ++dt) O[qi][dt] = (f32x4){0.f, 0.f, 0.f, 0.f};
  }
  int wkb, wke;
  if (MODE == 0) { wkb = max(kt_begin, w >> 1); wke = (w * 32 + 159) / 64 + 1; }
  else { wkb = 0; wke = (qpos0 + w * 32 + 31) / 64 + 1; }
  u32x4 rk[NKC], rv[NVC];
  auto gload = [&](int kt) {
#pragma unroll
    for (int i = 0; i < NKC; ++i) { const int c = tid + 256 * i, key = c / KCH, part = c % KCH; rk[i] = *(const u32x4*)(Kp + (unsigned)((kt * 64 + key) * krs + part * 8)); }
    if (MODE == 0) {
#pragma unroll
      for (int i = 0; i < NVC; ++i) { const int c = tid + 256 * i, key = c >> 3, part = c & 7; rv[i] = *(const u32x4*)(Vp + (unsigned)((kt * 64 + key) * vrs + part * 8)); }
    } else {
#pragma unroll
      for (int i = 0; i < NVC; ++i) { const int c = tid + 256 * i, dv = c >> 3, kc = c & 7; rv[i] = *(const u32x4*)(Vp + (unsigned)(dv * vrs + kt * 64 + kc * 8)); }
    }
  };
  auto sstore = [&]() {
#pragma unroll
    for (int i = 0; i < NKC; ++i) { const int c = tid + 256 * i, key = c / KCH, part = c % KCH; *(u32x4*)(Ks + key * KST + part * 8) = rk[i]; }
    if (MODE == 0) {
#pragma unroll
      for (int i = 0; i < NVC; ++i) {
        const int c = tid + 256 * i, key = c >> 3, part = c & 7;
        const int pos = (key & 32) + ((key >> 2) & 3) * 8 + ((key >> 4) & 1) * 4 + (key & 3);
#pragma unroll
        for (int e = 0; e < 8; ++e) Vt[(part * 8 + e) * VTS + pos] = (bf16_t)(rv[i][e >> 1] >> ((e & 1) * 16));
      }
    } else {
#pragma unroll
      for (int i = 0; i < NVC; ++i) {
        const int c = tid + 256 * i, dv = c >> 3, kc = c & 7;
        const int pos0 = (kc >> 2) * 32 + ((kc & 1) * 2) * 8 + ((kc >> 1) & 1) * 4;
        *(u32x2*)(Vt + dv * VTS + pos0) = (u32x2){rv[i].x, rv[i].y};
        *(u32x2*)(Vt + dv * VTS + pos0 + 8) = (u32x2){rv[i].z, rv[i].w};
      }
    }
  };
  gload(kt_begin);
  __syncthreads();
  sstore();
  __syncthreads();
  for (int kt = kt_begin; kt < kt_end; ++kt) {
    const bool more = kt + 1 < kt_end;
    if (more) gload(kt + 1);
    ATT_SCHED_BARRIER;
    bf16_t* Qs2 = Qs; asm volatile("" : "+v"(Qs2));
    if (kt >= wkb && kt < wke) {
      int path = 1; float cb = 0.f; bool need_mask = true;
      if (MODE == 2) { need_mask = (kt * 64 + 63) > (qpos0 + w * 32); path = need_mask ? 1 : 0; }
      if (MODE == 1) {
        need_mask = (kt * 64 + 63) > (qpos0 + w * 32);
        const int dmin = (qpos0 + w * 32) - (kt * 64 + 63);
        if (dmin >= 0) {
          const float blo = bias_lds[min(dmin, 2047)], bhi = bias_lds[min(dmin + 94, 2047)];
          if (((__float_as_uint(blo) ^ __float_as_uint(bhi)) & 31u) == 0u) { path = 0; cb = blo; }
        }
      }
      constexpr int QG = (DV == 128) ? ATT_QG_B : 2;
#pragma unroll
      for (int q0 = 0; q0 < 2; q0 += QG) {
        f32x4 S[QG][4];
#pragma unroll
        for (int t = 0; t < 4; ++t) {
          {
            const bf16x8 kf = *(const bf16x8*)(Ks + (t * 16 + fr) * KST + fq * 8);
#pragma unroll
            for (int qq = 0; qq < QG; ++qq) S[qq][t] = __builtin_amdgcn_mfma_f32_16x16x32_bf16(kf, *(const bf16x8*)(Qs2 + ((q0 + qq) * NKS) * 512), (f32x4){0.f, 0.f, 0.f, 0.f}, 0, 0, 0);
          }
#pragma unroll
          for (int ks = 1; ks < NKS; ++ks) {
            const bf16x8 kf = *(const bf16x8*)(Ks + (t * 16 + fr) * KST + ks * 32 + fq * 8);
#pragma unroll
            for (int qq = 0; qq < QG; ++qq) S[qq][t] = mfma16(kf, *(const bf16x8*)(Qs2 + ((q0 + qq) * NKS + ks) * 512), S[qq][t]);
          }
        }
        ATT_SCHED_BARRIER;
        bf16x8 pf[QG][2];
#pragma unroll
        for (int qq = 0; qq < QG; ++qq) {
          const int qi = q0 + qq;
          const int qrow = w * 32 + qi * 16 + fr;
          f32x4 P[4];
          float mn;
          if (path == 0) {
            float mx = fmax3(S[qq][0][0], S[qq][0][1], S[qq][0][2]);
            mx = fmax3(mx, S[qq][0][3], S[qq][1][0]); mx = fmax3(mx, S[qq][1][1], S[qq][1][2]); mx = fmax3(mx, S[qq][1][3], S[qq][2][0]);
            mx = fmax3(mx, S[qq][2][1], S[qq][2][2]); mx = fmax3(mx, S[qq][2][3], S[qq][3][0]); mx = fmax3(mx, S[qq][3][1], S[qq][3][2]);
            mx = fmax3(mx, S[qq][3][3], mx);
            mx = xmax_rows(mx);
            mn = fmax3(mrow[qi], mx * c1 + cb, mrow[qi]);
            const float off = cb - mn;
#pragma unroll
            for (int t = 0; t < 4; ++t) P[t] = S[qq][t] * c1 + off;
          } else {
            float mx = -1e30f;
#pragma unroll
            for (int t = 0; t < 4; ++t)
#pragma unroll
              for (int r = 0; r < 4; ++r) {
                const int j = kt * 64 + t * 16 + fq * 4 + r;
                float sx = S[qq][t][r] * c1;
                if (MODE == 1) {
                  const int dist = qpos0 + qrow - j;
                  sx += bias_lds[min(max(dist, 0), 2047)];
                  if (need_mask && dist < 0) sx = -1e30f;
                } else if (MODE == 2) {
                  if ((qpos0 + qrow - j) < 0) sx = -1e30f;
                } else {
                  const int rel = 128 + qrow - j;
                  sx += bias_lds[min(max(rel, 0), 128)];
                  if (rel < 0 || rel > 128 || j < jmin) sx = -1e30f;
                }
                P[t][r] = sx;
              }
#pragma unroll
            for (int t = 0; t < 4; ++t) { mx = fmax3(mx, P[t][0], P[t][1]); mx = fmax3(mx, P[t][2], P[t][3]); }
            mx = xmax_rows(mx);
            mn = fmax3(mrow[qi], mx, mx);
#pragma unroll
            for (int t = 0; t < 4; ++t) P[t] = P[t] - mn;
          }
          {
            const float alpha = fexp2(mrow[qi] - mn);
            lrow[qi] *= alpha;
#pragma unroll
            for (int dt = 0; dt < NDT; ++dt) O[qi][dt] *= alpha;
          }
          mrow[qi] = mn;
          f32x4 ls4 = (f32x4){0.f, 0.f, 0.f, 0.f};
#pragma unroll
          for (int t = 0; t < 4; ++t) {
#pragma unroll
            for (int r = 0; r < 4; ++r) P[t][r] = fexp2(P[t][r]);
            ls4 += P[t];
          }
          lrow[qi] += (ls4[0] + ls4[1]) + (ls4[2] + ls4[3]);
#pragma unroll
          for (int s2 = 0; s2 < 2; ++s2) {
            u32x4 pk;
            pk.x = pack2(P[2 * s2][0], P[2 * s2][1]); pk.y = pack2(P[2 * s2][2], P[2 * s2][3]);
            pk.z = pack2(P[2 * s2 + 1][0], P[2 * s2 + 1][1]); pk.w = pack2(P[2 * s2 + 1][2], P[2 * s2 + 1][3]);
            pf[qq][s2] = __builtin_bit_cast(bf16x8, pk);
          }
          ATT_SCHED_BARRIER;
        }
#pragma unroll
        for (int s2 = 0; s2 < 2; ++s2)
#pragma unroll
          for (int dt = 0; dt < NDT; ++dt) {
            const bf16x8 vf = *(const bf16x8*)(Vt + (dt * 16 + fr) * VTS + s2 * 32 + fq * 8);
#pragma unroll
            for (int qq = 0; qq < QG; ++qq) O[q0 + qq][dt] = mfma16(vf, pf[qq][s2], O[q0 + qq][dt]);
            if ((dt & (ATT_PVB - 1)) == (ATT_PVB - 1)) ATT_SCHED_BARRIER;
          }
      }
    }
    lds_barrier();
    if (more) { sstore(); lds_barrier(); }
  }
#pragma unroll
  for (int qi = 0; qi < 2; ++qi) lrow[qi] = xsum_rows(lrow[qi]);
}

__device__ __forceinline__ int next_item(int* counter, int* s_item, const int tid) {
  __syncthreads();
  if (tid == 0) *s_item = atomicAdd(counter, 1);
  __syncthreads();
  return *s_item;
}

__device__ void phase_attn(const Params& p, int l, unsigned char* smem, int cset = 0) {
  const int tid = opaque_tid(), lane = tid & 63, w = tid >> 6, fr = lane & 15, fq = lane >> 4;
  int* s_item = (int*)(smem + ATT_MISC_OFF);
  float* bias_lds = (float*)(smem + ATT_BIAS_OFF);
  const int xcd = blockIdx.x & 7;
#pragma unroll 1
  for (;;) {
    const int item = next_item(p.counters + ((cset * 4 + l) * 3 + 0) * 8 + xcd, s_item, tid);
    if (item >= 128) break;
    const int qb = 63 - (item >> 1), mp = item & 1;
    const int b = xcd >> 2, h = xcd & 3;
    for (int i = tid; i < 2048; i += NTHREADS) bias_lds[i] = p.biasB2[h * 2048 + i];
    const long tok0 = (long)b * SEQ + qb * 128;
    const bf16_t* Vp = p.vtB + (size_t)((b * 4 + h) * 128) * SEQ;
    const int kt_end = (qb * 128 + 127) / 64 + 1;
    f32x4 O[2][8]; float mr[2], lr[2];
    flash_block<64, 128, 1>(p.qkB + tok0 * 1024 + h * 128 + mp * 64, 1024, p.qkB + (long)b * SEQ * 1024 + 512 + h * 128 + mp * 64, 1024, Vp, SEQ, 0, kt_end,
                            qb * 128, 0, 0.125f * LOG2E, smem, O, mr, lr, tid);
#pragma unroll
    for (int qi = 0; qi < 2; ++qi) {
      const float inv = 1.f / lr[qi];
      const long tok = tok0 + w * 32 + qi * 16 + fr;
#pragma unroll
      for (int dt = 0; dt < 8; ++dt) store4bf(p.oB + ((size_t)mp * T_TOK + tok) * 512 + h * 128 + dt * 16 + fq * 4, O[qi][dt] * inv);
    }
  }
#pragma unroll 1
  for (;;) {
    const int item = next_item(p.counters + ((cset * 4 + l) * 3 + 1) * 8 + xcd, s_item, tid);
    if (item >= 96) break;
    const int lvl = item / 3, sel = item % 3;
    int bh, qb;
    if (sel < 2) { bh = xcd; qb = 63 - 2 * lvl - sel; } else { bh = 8 + (xcd >> 1); qb = 63 - 2 * lvl - (xcd & 1); }
    const int b = bh / 6, h = bh % 6;
    const long tok0 = (long)b * SEQ + qb * 128;
    const int kt_end = (qb * 128 + 127) / 64 + 1;
    f32x4 O[2][4]; float mr[2], lr[2];
    flash_block<96, 64, 2>(p.cq + tok0 * 576 + h * 96, 576, p.kC + (long)b * SEQ * 576 + h * 96, 576, p.vtC + (size_t)((b * 6 + h) * 64) * SEQ, SEQ,
                           0, kt_end, qb * 128, 0, 0.10206207261596575f * LOG2E, smem, O, mr, lr, tid);
#pragma unroll
    for (int qi = 0; qi < 2; ++qi) {
      const float inv = 1.f / lr[qi];
      const long tok = tok0 + w * 32 + qi * 16 + fr;
#pragma unroll
      for (int dt = 0; dt < 4; ++dt) store4bf(p.y + tok * 1280 + 896 + h * 64 + dt * 16 + fq * 4, O[qi][dt] * inv);
    }
  }
#pragma unroll 1
  for (;;) {
    const int a = next_item(p.counters + ((cset * 4 + l) * 3 + 2) * 8, s_item, tid);
    if (a >= 2304) break;
    const int g = a / 768, rem = a % 768, b = rem / 384, h = (rem >> 6) % 6, blk = rem & 63;
    const int d = g == 0 ? 1 : (g == 1 ? 4 : 16);
    const int r = blk % d, n = blk / d;
    for (int i = tid; i < 129; i += NTHREADS) bias_lds[i] = p.biasA2[(g * 6 + h) * 129 + i];
    const long row_q0 = (long)b * SEQ + (long)n * 128 * d + r;
    const long row_k0 = row_q0 - 128L * d;
    f32x4 O[2][4]; float mr[2], lr[2];
    flash_block<64, 64, 0>(p.qkvA + row_q0 * 1152 + h * 64, 1152 * d, p.qkvA + row_k0 * 1152 + 384 + h * 64, 1152 * d,
                           p.qkvA + row_k0 * 1152 + 768 + h * 64, 1152 * d, n == 0 ? 2 : 0, 4, 0, n == 0 ? 128 : 0, 0.125f * LOG2E, smem, O, mr, lr, tid);
#pragma unroll
    for (int qi = 0; qi < 2; ++qi) {
      const float inv = 1.f / lr[qi];
      const long tok = row_q0 + (long)(w * 32 + qi * 16 + fr) * d;
#pragma unroll
      for (int dt = 0; dt < 4; ++dt) store4bf(p.oA + ((size_t)g * T_TOK + tok) * 384 + h * 64 + dt * 16 + fq * 4, O[qi][dt] * inv);
      if (fq == 0) p.lseA[((size_t)g * T_TOK + tok) * 6 + h] = (mr[qi] + __log2f(lr[qi])) * LN2;
    }
  }
}

__device__ void phase_mergeA(const Params& p, int l) {
  const int tid = opaque_tid();
  const int total = T_TOK * 6 * 8;
  for (int i = blockIdx.x * NTHREADS + tid; i < total; i += gridDim.x * NTHREADS) {
    const int tok = i / 48, rem = i % 48, h = rem >> 3, c = rem & 7;
    const float l0 = p.lseA[(size_t)tok * 6 + h], l1 = p.lseA[((size_t)T_TOK + tok) * 6 + h], l2 = p.lseA[((size_t)2 * T_TOK + tok) * 6 + h];
    const float mx = fmaxf(l0, fmaxf(l1, l2));
    float w0 = __expf(l0 - mx), w1 = __expf(l1 - mx), w2 = __expf(l2 - mx);
    const float inv = 1.f / (w0 + w1 + w2);
    w0 *= inv; w1 *= inv; w2 *= inv;
    const size_t off = (size_t)tok * 384 + h * 64 + c * 8;
    const u32x4 a0 = *(const u32x4*)(p.oA + off), a1 = *(const u32x4*)(p.oA + (size_t)T_TOK * 384 + off), a2 = *(const u32x4*)(p.oA + (size_t)2 * T_TOK * 384 + off);
    u32x4 o;
#pragma unroll
    for (int e = 0; e < 4; ++e) {
      const float lo = w0 * bflo(a0[e]) + w1 * bflo(a1[e]) + w2 * bflo(a2[e]);
      const float hi = w0 * bfhi(a0[e]) + w1 * bfhi(a1[e]) + w2 * bfhi(a2[e]);
      o[e] = pack2(lo, hi);
    }
    *(u32x4*)(p.y + (size_t)tok * 1280 + h * 64 + c * 8) = o;
  }
  const float lam = p.lam[l * 2], sc0 = 1.f - p.lam[l * 2 + 1];
  const float* gs = p.g_subln + l * 128;
  const int totalB = T_TOK * 4 * 16;
  for (int i = blockIdx.x * NTHREADS + tid; i < totalB; i += gridDim.x * NTHREADS) {
    const int c = i & 15, th = i >> 4, h = th & 3, tok = th >> 2;
    const size_t off = (size_t)tok * 512 + h * 128 + c * 8;
    const u32x4 a1 = *(const u32x4*)(p.oB + off), a2 = *(const u32x4*)(p.oB + (size_t)T_TOK * 512 + off);
    float v[8]; float ss = 0.f;
#pragma unroll
    for (int e = 0; e < 4; ++e) {
      v[2 * e] = bflo(a1[e]) - lam * bflo(a2[e]); v[2 * e + 1] = bfhi(a1[e]) - lam * bfhi(a2[e]);
      ss += v[2 * e] * v[2 * e] + v[2 * e + 1] * v[2 * e + 1];
    }
    ss += __shfl_xor(ss, 1); ss += __shfl_xor(ss, 2); ss += __shfl_xor(ss, 4); ss += __shfl_xor(ss, 8);
    const float sc = rsqrtf(ss * (1.f / 128.f) + 1e-6f) * sc0;
    const f32x4 g0 = *(const f32x4*)(gs + c * 8), g1 = *(const f32x4*)(gs + c * 8 + 4);
    u32x4 o;
    o.x = pack2(v[0] * g0[0] * sc, v[1] * g0[1] * sc); o.y = pack2(v[2] * g0[2] * sc, v[3] * g0[3] * sc);
    o.z = pack2(v[4] * g1[0] * sc, v[5] * g1[1] * sc); o.w = pack2(v[6] * g1[2] * sc, v[7] * g1[3] * sc);
    *(u32x4*)(p.y + (size_t)tok * 1280 + 384 + h * 128 + c * 8) = o;
  }
}

__device__ __forceinline__ unsigned ord_bits(float x) { const unsigned u = __float_as_uint(x); return u ^ ((unsigned)((int)u >> 31) | 0x80000000u); }
__device__ __forceinline__ float unord_bits(unsigned k) { return __uint_as_float(k ^ ((k & 0x80000000u) ? 0x80000000u : 0xffffffffu)); }
__device__ __forceinline__ unsigned umax3(unsigned a, unsigned b, unsigned c) { return max(max(a, b), c); }

__device__ void phase_topk(const Params& p, int l, unsigned char* smem) {
  const int tid = opaque_tid(), lane = tid & 63, w = tid >> 6, fr = lane & 15, fq = lane >> 4;
  int* il = (int*)(smem + w * 2048);
  const bf16_t* sk = p.skeys + (size_t)l * 8 * 2 * 128 * 64;
  const int nunits = 1024 * 8, gw = gridDim.x * 4;
#pragma unroll 1
  for (int u = blockIdx.x * 4 + w; u < nunits; u += gw) {
    const int tok0 = (u >> 3) * 16, h = u & 7;
    unsigned key[2][32];
#pragma unroll
    for (int pp = 0; pp < 2; ++pp) {
      bf16x8 qf[2];
#pragma unroll
      for (int ks = 0; ks < 2; ++ks) qf[ks] = *(const bf16x8*)(p.pq + (size_t)(tok0 + fr) * 1024 + h * 128 + pp * 64 + ks * 32 + fq * 8);
#pragma unroll
      for (int kt = 0; kt < 8; ++kt) {
        const bf16_t* kp = sk + ((size_t)((h * 2 + pp) * 128 + kt * 16 + fr)) * 64 + fq * 8;
        f32x4 acc = mfma16(*(const bf16x8*)kp, qf[0], (f32x4){0.f, 0.f, 0.f, 0.f});
        acc = mfma16(*(const bf16x8*)(kp + 32), qf[1], acc);
#pragma unroll
        for (int r = 0; r < 4; ++r) key[pp][kt * 4 + r] = (ord_bits(acc[r]) & 0xffffff80u) | (unsigned)(127 - (kt * 16 + fq * 4 + r));
      }
    }
    float sval[2][16];
#pragma unroll
    for (int pp = 0; pp < 2; ++pp) {
#pragma unroll
      for (int r = 0; r < 16; ++r) {
        unsigned best = 0u;
#pragma unroll
        for (int i = 0; i < 32; i += 2) best = umax3(best, key[pp][i], key[pp][i + 1]);
        best = xswap32_max_u(xswap16_max_u(best));
#pragma unroll
        for (int i = 0; i < 32; ++i) key[pp][i] = (key[pp][i] == best) ? 0u : key[pp][i];
        sval[pp][r] = unord_bits(best & 0xffffff80u);
        if (fq == 0) il[(fr * 2 + pp) * 16 + r] = 127 - (int)(best & 127u);
      }
    }
    unsigned ck[21];
    {
      int sl = 0;
#pragma unroll
      for (int gi = 0; gi < 4; ++gi) {
        const float a = fq == 0 ? sval[0][4 * gi] : (fq == 1 ? sval[0][4 * gi + 1] : (fq == 2 ? sval[0][4 * gi + 2] : sval[0][4 * gi + 3]));
        const int irow = fq + 4 * gi;
        const int nj = gi == 0 ? 16 : (gi == 1 ? 3 : 1);
#pragma unroll
        for (int j = 0; j < nj; ++j) {
          const bool valid = (irow + 1) * (j + 1) <= 16;
          const unsigned k2 = (ord_bits(a + sval[1][j]) & 0xffffff00u) | (unsigned)(255 - (irow * 16 + j));
          ck[sl++] = valid ? k2 : 0u;
        }
      }
    }
    float bs[16]; int be[16];
#pragma unroll
    for (int r = 0; r < 16; ++r) {
      unsigned best = 0u;
#pragma unroll
      for (int i = 0; i < 20; i += 2) best = umax3(best, ck[i], ck[i + 1]);
      best = max(best, ck[20]);
      best = xswap32_max_u(xswap16_max_u(best));
#pragma unroll
      for (int i = 0; i < 21; ++i) ck[i] = (ck[i] == best) ? 0u : ck[i];
      const int c = 255 - (int)(best & 255u);
      bs[r] = unord_bits(best & 0xffffff00u);
      be[r] = il[(fr * 2 + 0) * 16 + (c >> 4)] * 128 + il[(fr * 2 + 1) * 16 + (c & 15)];
    }
    if (fq == 0) {
      float e[16]; float tot = 0.f;
#pragma unroll
      for (int r = 0; r < 16; ++r) { e[r] = __expf(bs[r] - bs[0]); tot += e[r]; }
      const float inv = 1.f / tot;
      const size_t ob = ((size_t)(tok0 + fr) * 8 + h) * 16;
#pragma unroll
      for (int c4 = 0; c4 < 4; ++c4) {
        *(f32x4*)(p.pgate + ob + c4 * 4) = (f32x4){e[c4 * 4] * inv, e[c4 * 4 + 1] * inv, e[c4 * 4 + 2] * inv, e[c4 * 4 + 3] * inv};
        *(int4*)(p.pidx + ob + c4 * 4) = make_int4(be[c4 * 4], be[c4 * 4 + 1], be[c4 * 4 + 2], be[c4 * 4 + 3]);
      }
    }
  }
}

__device__ __forceinline__ float gelu_exact(float x) { return 0.5f * x * (1.f + erff(x * 0.70710678118654752f)); }

typedef float f32x2 __attribute__((ext_vector_type(2)));
__device__ void phase_experts(const Params& p, int l) {
  const int tid = opaque_tid(), lane = tid & 63, w = tid >> 6;
  const unsigned char* U = p.pu8 + (size_t)l * 16384 * 1024;
  const float* gf = p.g_ffn + l * 1024;
  const int tstep = gridDim.x * 4;
  int tok = blockIdx.x * 4 + w;
  if (tok >= T_TOK) return;
  u32x4 rbuf[2][16];
  f32x4 xr[4];
  int id0 = p.pidx[(size_t)tok * 128 + lane], id1 = p.pidx[(size_t)tok * 128 + 64 + lane];
#pragma unroll
  for (int c = 0; c < 4; ++c) xr[c] = *(const f32x4*)(p.xcur + (size_t)tok * 1024 + lane * 16 + c * 4);
#pragma unroll
  for (int j = 0; j < 16; ++j) {
    const int row = __builtin_amdgcn_readlane(id0, j);
    rbuf[0][j] = *(const u32x4*)(U + (size_t)row * 1024 + lane * 16);
  }
#pragma unroll 1
  for (; tok < T_TOK; tok += tstep) {
    const int tokn = min(tok + tstep, T_TOK - 1);
    const int idn0 = p.pidx[(size_t)tokn * 128 + lane], idn1 = p.pidx[(size_t)tokn * 128 + 64 + lane];
    f32x4 xn[4];
#pragma unroll
    for (int c = 0; c < 4; ++c) xn[c] = *(const f32x4*)(p.xcur + (size_t)tokn * 1024 + lane * 16 + c * 4);
    const float g0 = p.pgate[(size_t)tok * 128 + lane], g1 = p.pgate[(size_t)tok * 128 + 64 + lane];
    float hv[16];
    float ss = 0.f;
#pragma unroll
    for (int c = 0; c < 4; ++c)
#pragma unroll
      for (int e = 0; e < 4; ++e) ss += xr[c][e] * xr[c][e];
    ss = wave_sum(ss);
    const float rstd = rsqrtf(ss * (1.f / 1024.f) + 1e-6f);
#pragma unroll
    for (int c = 0; c < 4; ++c) {
      const f32x4 g = *(const f32x4*)(gf + lane * 16 + c * 4);
#pragma unroll
      for (int e = 0; e < 4; ++e) hv[c * 4 + e] = xr[c][e] * rstd * g[e];
    }
    float d0 = 0.f, d1 = 0.f;
#pragma unroll
    for (int bi = 0; bi < 8; ++bi) {
      {
        const int nb = (bi + 1) & 7;
        const int idv = bi == 7 ? idn0 : (nb < 4 ? id0 : id1);
#pragma unroll
        for (int j = 0; j < 16; ++j) {
          const int row = __builtin_amdgcn_readlane(idv, (nb & 3) * 16 + j);
          rbuf[(bi + 1) & 1][j] = *(const u32x4*)(U + (size_t)row * 1024 + lane * 16);
        }
      }
      u32x4 (&ru)[16] = rbuf[bi & 1];
      float sj[16];
#pragma unroll
      for (int j = 0; j < 16; ++j) {
        float acc = 0.f;
#pragma unroll
        for (int c = 0; c < 4; ++c) {
          const f32x2 a = __builtin_amdgcn_cvt_pk_f32_fp8((int)ru[j][c], false), b2 = __builtin_amdgcn_cvt_pk_f32_fp8((int)ru[j][c], true);
          acc += a.x * hv[c * 4] + a.y * hv[c * 4 + 1] + b2.x * hv[c * 4 + 2] + b2.y * hv[c * 4 + 3];
        }
        sj[j] = acc;
      }
#pragma unroll
      for (int hw = 8; hw >= 1; hw >>= 1) {
        const bool up = (lane & hw) != 0;
#pragma unroll
        for (int k = 0; k < hw; ++k) {
          const float send = up ? sj[k] : sj[k + hw], keep = up ? sj[k + hw] : sj[k];
          sj[k] = keep + __shfl_xor(send, hw);
        }
      }
      float tot = sj[0];
      tot = xsum_rows(tot);
      if ((lane >> 4) == (bi & 3)) { if (bi < 4) d0 = tot; else d1 = tot; }
    }
    const float w0 = gelu_exact(d0 * (1.f / 256.f)) * g0 * (1.f / 64.f), w1 = gelu_exact(d1 * (1.f / 256.f)) * g1 * (1.f / 64.f);
    p.pw[(size_t)tok * 128 + lane] = w0;
    p.pw[(size_t)tok * 128 + 64 + lane] = w1;
    id0 = idn0; id1 = idn1;
#pragma unroll
    for (int c = 0; c < 4; ++c) xr[c] = xn[c];
  }
}

__device__ void phase_experts_v(const Params& p, int l) {
  const int tid = opaque_tid(), lane = tid & 63, w = tid >> 6;
  const int x = blockIdx.x & 7, slot = (blockIdx.x >> 3) * 4 + w, nslot = (gridDim.x >> 3) * 4;
  const int e8 = lane >> 3, c = lane & 7;
  const unsigned char* Vb = p.pv8 + (size_t)l * 16384 * 1024 + x * 128;
  const bool last = (l == NLAYER - 1);
  const int colb = x * 128 + c * 16 + ((lane & 32) ? 8 : 0) + ((lane & 16) ? 4 : 0) + ((lane & 8) ? 2 : 0);
  int rows[16]; float wt[16];
#pragma unroll
  for (int j = 0; j < 16; ++j) { rows[j] = p.pidx[(unsigned)(slot * 128 + e8) + 8 * j]; wt[j] = p.pw[(unsigned)(slot * 128 + e8) + 8 * j]; }
#pragma unroll 1
  for (int tok = slot; tok < T_TOK; tok += nslot) {
    const f32x2 xin = *(const f32x2*)(p.xcur + (unsigned)(tok * 1024 + colb));
    u32x4 rv[16];
#pragma unroll
    for (int j = 0; j < 16; ++j) rv[j] = *(const u32x4*)(Vb + (unsigned)(rows[j] * 1024 + c * 16));
    const int tokn = min(tok + nslot, T_TOK - 1);
    int rown[16]; float wtc[16];
#pragma unroll
    for (int j = 0; j < 16; ++j) { wtc[j] = wt[j]; rown[j] = p.pidx[(unsigned)(tokn * 128 + e8) + 8 * j]; wt[j] = p.pw[(unsigned)(tokn * 128 + e8) + 8 * j]; }
    float acc[16];
#pragma unroll
    for (int i = 0; i < 16; ++i) acc[i] = 0.f;
#pragma unroll
    for (int j = 0; j < 16; ++j)
#pragma unroll
      for (int q = 0; q < 4; ++q) {
        const f32x2 a = __builtin_amdgcn_cvt_pk_f32_fp8((int)rv[j][q], false), b2 = __builtin_amdgcn_cvt_pk_f32_fp8((int)rv[j][q], true);
        acc[q * 4] += wtc[j] * a.x; acc[q * 4 + 1] += wtc[j] * a.y; acc[q * 4 + 2] += wtc[j] * b2.x; acc[q * 4 + 3] += wtc[j] * b2.y;
      }
#pragma unroll
    for (int j = 0; j < 16; ++j) rows[j] = rown[j];
#pragma unroll
    for (int hw = 8; hw >= 2; hw >>= 1) {
      const int msk = hw * 4;
      const bool up = (lane & msk) != 0;
#pragma unroll
      for (int k = 0; k < hw; ++k) {
        const float send = up ? acc[k] : acc[k + hw], keep = up ? acc[k + hw] : acc[k];
        acc[k] = keep + __shfl_xor(send, msk);
      }
    }
    const float x0 = xin[0] + acc[0], x1 = xin[1] + acc[1];
    *(f32x2*)(p.xcur + (unsigned)(tok * 1024 + colb)) = (f32x2){x0, x1};
    if (!last) *(unsigned*)(p.xb + (unsigned)(tok * 1024 + colb)) = pack2(x0, x1);
    const float ss = wave_sum(x0 * x0 + x1 * x1);
    if (lane == 0) p.ssqn[tok * 8 + x] = ss;
  }
}

__device__ void phase_final(const Params& p) {
  const int tid = opaque_tid(), lane = tid & 63, w = tid >> 6;
  for (int tok = blockIdx.x * 4 + w; tok < T_TOK; tok += gridDim.x * 4) {
    const f32x4 s0 = *(const f32x4*)(p.ssqn + tok * 8), s1 = *(const f32x4*)(p.ssqn + tok * 8 + 4);
    const float rn = rsqrtf(((s0[0] + s0[1]) + (s0[2] + s0[3]) + (s1[0] + s1[1]) + (s1[2] + s1[3])) * (1.f / 1024.f) + 1e-6f);
#pragma unroll
    for (int q = 0; q < 4; ++q) {
      const f32x4 v = *(const f32x4*)(p.xcur + (size_t)tok * 1024 + q * 256 + lane * 4);
      const f32x4 g = *(const f32x4*)(p.g_final + q * 256 + lane * 4);
      *(f32x4*)(p.out + (size_t)tok * 1024 + q * 256 + lane * 4) = v * g * rn;
    }
  }
}

__device__ int t5_bucket(int n) {
  if (n < 16) return n;
  int v = 16 + (int)(log((double)n / 16.0) / log(128.0) * 16.0);
  return v > 31 ? 31 : v;
}

__device__ void phase_prologue(const Params& p, unsigned char* smem) {
  const int tid = opaque_tid(), lane = tid & 63, w = tid >> 6;
  const int gtid = blockIdx.x * NTHREADS + tid, gsz = gridDim.x * NTHREADS;
  {
    bf16_t* tl = (bf16_t*)smem;
    for (int t = blockIdx.x; t < p.total_tr_tiles; t += gridDim.x) {
      int ji = 0;
      while (ji + 1 < p.njobs && p.jobs[ji + 1].tile0 <= t) ++ji;
      const TrJob& jb = p.jobs[ji];
      const int lt = t - jb.tile0, kt = lt / jb.ntn, nt = lt % jb.ntn;
      __syncthreads();
      for (int i = tid; i < 64 * 64; i += NTHREADS) {
        const int kk = i >> 6, nn = i & 63;
        const int n = nt * 64 + nn, k = kt * 64 + kk;
        float v = 0.f;
        if (n < jb.N) { v = jb.src[(size_t)k * jb.lds + n]; if (jb.g) v *= jb.g[k]; }
        tl[nn * 66 + kk] = (bf16_t)(pack2(v, 0.f) & 0xffffu);
      }
      __syncthreads();
      for (int i = tid; i < 64 * 32; i += NTHREADS) {
        const int nn = i >> 5, kp = i & 31;
        const int n = nt * 64 + nn;
        if (n < jb.N) *(unsigned*)(jb.dst + (size_t)n * jb.ldd + kt * 64 + kp * 2) = (unsigned)tl[nn * 66 + kp * 2] | ((unsigned)tl[nn * 66 + kp * 2 + 1] << 16);
      }
    }
  }
  {
    const size_t k8 = (size_t)NLAYER * 8 * 2 * 128 * 64 / 8;
    for (size_t i = gtid; i < k8; i += gsz) {
      const f32x4 a = *(const f32x4*)(p.sub_keys + i * 8), b = *(const f32x4*)(p.sub_keys + i * 8 + 4);
      *(u32x4*)(p.skeys + i * 8) = (u32x4){pack2(a[0], a[1]), pack2(a[2], a[3]), pack2(b[0], b[1]), pack2(b[2], b[3])};
    }
  }
  for (int i = gtid; i < NLAYER * 96 * 1024 / 2; i += gsz) { const int l = i / (96 * 512), r = i % (96 * 512); ((unsigned*)(p.Wt_in + ((size_t)l * INC + 6176) * 1024))[r] = 0u; }
  for (int i = gtid; i < NLAYER * 64 * 256 / 2; i += gsz) { const int l = i / (64 * 128), r = i % (64 * 128); ((unsigned*)(p.Wt_uq + ((size_t)l * 640 + 576) * 256))[r] = 0u; }
  for (int i = gtid; i < 3 * 6 * 129; i += gsz) {
    const int g = i / (6 * 129), h = (i / 129) % 6, rel = i % 129;
    const int d = g == 0 ? 1 : (g == 1 ? 4 : 16);
    p.biasA2[i] = p.rel_bias[t5_bucket(rel * d) * 10 + h] * LOG2E;
  }
  for (int i = gtid; i < 4 * 2048; i += gsz) {
    const int h = i >> 11, dist = i & 2047, bk = t5_bucket(dist);
    p.biasB2[i] = __uint_as_float((__float_as_uint(p.rel_bias[bk * 10 + 6 + h] * LOG2E) & ~31u) | (unsigned)bk);
  }
  for (int i = gtid; i < SEQ * 16; i += gsz) {
    const int pos = i >> 4, j = i & 15;
    const float inv = powf(10000.f, -(float)j / 16.f);
    const float ang = (float)pos * inv;
    p.ropec[i] = (float)cos((double)ang); p.ropes[i] = (float)sin((double)ang);
  }
  if (blockIdx.x == 0 && w < NLAYER) {
    const int l = w;
    float a = wave_sum(p.lam_q1[l * 64 + lane] * p.lam_k1[l * 64 + lane]);
    float b = wave_sum(p.lam_q2[l * 64 + lane] * p.lam_k2[l * 64 + lane]);
    const float li = 0.8f - 0.6f * expf(-0.3f * (float)l);
    if (lane == 0) { p.lam[l * 2] = expf(a) - expf(b) + li; p.lam[l * 2 + 1] = li; for (int c = 0; c < 48; ++c) p.counters[c * 4 + l] = 0; }
  }
  for (int tok = blockIdx.x * 4 + w; tok < T_TOK; tok += gridDim.x * 4) {
    f32x4 v[4]; float ss = 0.f;
#pragma unroll
    for (int q = 0; q < 4; ++q) { v[q] = *(const f32x4*)(p.x + (size_t)tok * 1024 + q * 256 + lane * 4); ss += v[q][0] * v[q][0] + v[q][1] * v[q][1] + v[q][2] * v[q][2] + v[q][3] * v[q][3]; }
    ss = wave_sum(ss);
    if (lane < 8) p.ssqn[tok * 8 + lane] = lane == 0 ? ss : 0.f;
#pragma unroll
    for (int q = 0; q < 4; ++q) {
      store4bf(p.xb + (size_t)tok * 1024 + q * 256 + lane * 4, v[q]);
    }
  }
}

#define XB_TMO      128
#define XB_XCNT(j)  (256  + 64 * (j))
#define XB_XSUB(j)  (1280 + 64 * (j))
#define XB_XGEN(j)  (2304 + 64 * (j))
#define XB_TOP      3328
#define XB_TOPGEN   3392
#define XCD_BAR_WORDS 3456
#define XB_SPIN_CAP (1u << 20)
__device__ __forceinline__ unsigned xb_ld(unsigned* p)              { return __hip_atomic_load(p, __ATOMIC_RELAXED, __HIP_MEMORY_SCOPE_AGENT); }
__device__ __forceinline__ unsigned xb_add(unsigned* p, unsigned v) { return __hip_atomic_fetch_add(p, v, __ATOMIC_RELAXED, __HIP_MEMORY_SCOPE_AGENT); }
__device__ __forceinline__ unsigned xb_xcc_id() { return (unsigned)__builtin_amdgcn_s_getreg((3 << 11) | 20) & 0xFu; }
#define XB_SPIN(cond, bar) do { unsigned _sp = 0; while (cond) { __builtin_amdgcn_s_sleep(1); \
    if ((++_sp & 255u) == 0u) { if (xb_ld(&(bar)[XB_TMO])) break; if (_sp > XB_SPIN_CAP) { atomicAdd(&(bar)[XB_TMO], 1u); break; } } } } while (0)
struct XcdBarrier { unsigned* bar; unsigned x; volatile unsigned* st; };
__device__ __forceinline__ XcdBarrier xcd_barrier_post(unsigned* bar, volatile unsigned* st) {
  XcdBarrier b; b.bar = bar; b.x = xb_xcc_id(); b.st = st;
  if (threadIdx.x == 0) (void)xb_add(&bar[XB_XCNT(b.x)], 1u);
  return b;
}
__device__ __forceinline__ void xcd_barrier_complete(unsigned* bar, unsigned x, unsigned& nloc, unsigned& nx) {
  const unsigned G = gridDim.x;
  unsigned sum, cnt, mine, sp = 0u;
  for (;;) {
    sum = 0u; cnt = 0u; mine = 0u;
#pragma unroll
    for (unsigned j = 0; j < 16; ++j) { const unsigned c = xb_ld(&bar[XB_XCNT(j)]); sum += c; cnt += (c > 0u) ? 1u : 0u; mine = (j == x) ? c : mine; }
    if (sum == G) break;
    __builtin_amdgcn_s_sleep(1);
    if ((++sp & 255u) == 0u) { if (xb_ld(&bar[XB_TMO])) break; if (sp > XB_SPIN_CAP) { atomicAdd(&bar[XB_TMO], 1u); break; } }
  }
  nloc = mine > 0u ? mine : 1u; nx = cnt > 0u ? cnt : 1u;
}
__device__ __forceinline__ void xcd_barrier(const XcdBarrier& b0) {
  asm volatile("s_waitcnt vmcnt(0)" ::: "memory");
  __syncthreads();
  if (threadIdx.x == 0) {
    XcdBarrier b; b.x = xb_xcc_id();
    { unsigned* t = b0.bar; asm volatile("" : "+s"(t)); b.bar = t; }
    { volatile unsigned* t = b0.st; asm volatile("" : "+s"(t)); b.st = t; }
    unsigned* bar = b.bar;
    __builtin_amdgcn_s_waitcnt(0);
    unsigned nloc = b.st[0], nx = b.st[1];
    if (nloc == 0u) { xcd_barrier_complete(bar, b.x, nloc, nx); b.st[0] = nloc; b.st[1] = nx; }
    const unsigned old = xb_add(&bar[XB_XSUB(b.x)], 1u);
    const unsigned gen = old / nloc;
    if (old + 1u == (gen + 1u) * nloc) {
      __builtin_amdgcn_fence(__ATOMIC_RELEASE, "agent");
      asm volatile("s_waitcnt vmcnt(0)" ::: "memory");
      const unsigned og = xb_add(&bar[XB_TOP], 1u);
      const unsigned tg = og / nx;
      if (og + 1u == (tg + 1u) * nx) xb_add(&bar[XB_TOPGEN], 1u);
      else XB_SPIN(xb_ld(&bar[XB_TOPGEN]) == tg, bar);
      __builtin_amdgcn_fence(__ATOMIC_ACQUIRE, "agent");
      xb_add(&bar[XB_XGEN(b.x)], 1u);
      asm volatile("s_waitcnt vmcnt(0)" ::: "memory");
    } else {
      XB_SPIN(xb_ld(&bar[XB_XGEN(b.x)]) == gen, bar);
      __builtin_amdgcn_fence(__ATOMIC_ACQUIRE, "agent");
      asm volatile("s_waitcnt vmcnt(0)" ::: "memory");
    }
  }
  __syncthreads();
}

extern "C" __global__ void __launch_bounds__(NTHREADS, 2) mega(Params p) {
  cg::grid_group grid = cg::this_grid();
  extern __shared__ __attribute__((aligned(16))) unsigned char smem[];
  volatile unsigned* st = (volatile unsigned*)(smem + SMEM_BYTES - 16);
  if (threadIdx.x < 2) st[threadIdx.x] = 0u;
  __syncthreads();
  const XcdBarrier xb = xcd_barrier_post(p.bar, st);
  phase_prologue(p, smem);
  if (p.njobs < 0) grid.sync();
  xcd_barrier(xb);
#ifdef PROBE_SYNC
  for (int i = 0; i < 100; ++i) xcd_barrier(xb);
#endif
#pragma unroll 1
  for (int l = 0; l < NLAYER; ++l) {
    phase_inproj(p, l, smem);
    xcd_barrier(xb);
    phase_cup(p, l, smem);
    xcd_barrier(xb);
    phase_attn(p, l, smem);
    xcd_barrier(xb);
    phase_mergeA(p, l);
    xcd_barrier(xb);
    phase_branch(p, l, smem);
    xcd_barrier(xb);
    phase_wout(p, l, smem);
    xcd_barrier(xb);
    phase_pq(p, l, smem);
    xcd_barrier(xb);
    phase_topk(p, l, smem);
    xcd_barrier(xb);
    phase_experts(p, l);
    xcd_barrier(xb);
    phase_experts_v(p, l);
    xcd_barrier(xb);
  }
  phase_final(p);
}

extern "C" void kernel_launch(void* const* d_in, const int* in_sizes, int n_in, void* d_out, int out_size, void* d_ws, size_t ws_size,
                              hipStream_t stream) {
  (void)in_sizes; (void)n_in; (void)out_size;
  constexpr size_t kDynLds = SMEM_BYTES;
  static int grid_blocks = 0;
  if (!grid_blocks) {
    int dev = 0, cus = 0, per_cu = 0;
    (void)hipGetDevice(&dev);
    (void)hipDeviceGetAttribute(&cus, hipDeviceAttributeMultiprocessorCount, dev);
    (void)hipFuncSetAttribute((const void*)mega, hipFuncAttributeMaxDynamicSharedMemorySize, (int)kDynLds);
    (void)hipOccupancyMaxActiveBlocksPerMultiprocessor(&per_cu, mega, NTHREADS, kDynLds);
    if (per_cu > 2) per_cu = 2;
    if (per_cu < 1) per_cu = 1;
    grid_blocks = cus * per_cu;
    grid_blocks -= grid_blocks % 8;
  }
  const float* const* in = (const float* const*)d_in;
  Params p;
  memset(&p, 0, sizeof(p));
  p.x = in[0]; p.rel_bias = in[1]; p.lam_q1 = in[8]; p.lam_k1 = in[9]; p.lam_q2 = in[10]; p.lam_k2 = in[11]; p.g_subln = in[12];
  p.peer_u = in[20]; p.peer_v = in[21]; p.sub_keys = in[19]; p.g_final = in[22]; p.g_ffn = in[17];
  p.out = (float*)d_out;
  size_t off = 0;
  auto alloc = [&](size_t bytes) { void* r = (char*)d_ws + off; off += (bytes + 255) & ~(size_t)255; return r; };
  const size_t T = T_TOK;
  p.xcur = (float*)alloc(T * 1024 * 4); p.xb = (bf16_t*)alloc(T * 1024 * 2); p.qkvA = (bf16_t*)alloc(T * 1152 * 2); p.qkB = (bf16_t*)alloc(T * 1024 * 2);
  p.vtB = (bf16_t*)alloc(T * 512 * 2); p.cq_lat = (bf16_t*)alloc(T * 256 * 2); p.ckv_lat = (bf16_t*)alloc(T * 128 * 2);
  p.ssq_cq = (float*)alloc(T * 4 * 4); p.ssq_ckv = (float*)alloc(T * 2 * 4); p.gates = (bf16_t*)alloc(T * 3072 * 2); p.cq = (bf16_t*)alloc(T * 576 * 2);
  p.kC = (bf16_t*)alloc(T * 576 * 2); p.vtC = (bf16_t*)alloc(T * 384 * 2); p.oA = (bf16_t*)alloc(3 * T * 384 * 2); p.lseA = (float*)alloc(3 * T * 6 * 4); p.oB = (bf16_t*)alloc(2 * T * 512 * 2);
  p.y = (bf16_t*)alloc(T * 1280 * 2); p.mix = (bf16_t*)alloc(T * 1024 * 2); p.ssq2 = (float*)alloc(T * 16 * 4); p.pq = (bf16_t*)alloc(T * 1024 * 2);
  p.pidx = (int*)alloc(T * 128 * 4); p.pgate = (float*)alloc(T * 128 * 4); p.pw = (float*)alloc(T * 128 * 4); p.ssqn = (float*)alloc(T * 8 * 4);
  p.Wt_in = (bf16_t*)alloc((size_t)NLAYER * INC * 1024 * 2); p.Wt_uq = (bf16_t*)alloc((size_t)NLAYER * 640 * 256 * 2); p.Wt_ukv = (bf16_t*)alloc((size_t)NLAYER * 768 * 128 * 2);
  p.Wt_br = (bf16_t*)alloc((size_t)NLAYER * 1024 * 1280 * 2); p.Wt_out = (bf16_t*)alloc((size_t)NLAYER * 1024 * 1024 * 2); p.Wt_pq = (bf16_t*)alloc((size_t)NLAYER * 1024 * 1024 * 2);
  p.skeys = (bf16_t*)alloc((size_t)NLAYER * 8 * 2 * 128 * 64 * 2); p.pu8 = (unsigned char*)alloc((size_t)NLAYER * 16384 * 1024); p.pv8 = (unsigned char*)alloc((size_t)NLAYER * 16384 * 1024);
  p.biasA2 = (float*)alloc(3 * 6 * 129 * 4); p.biasB2 = (float*)alloc(4 * 2048 * 4); p.ropec = (float*)alloc(SEQ * 16 * 4); p.ropes = (float*)alloc(SEQ * 16 * 4);
  p.lam = (float*)alloc(64); p.counters = (int*)alloc(1024); p.bar = (unsigned*)alloc(XCD_BAR_WORDS * 4);
  if (off > ws_size) fprintf(stderr, "workspace too small: need %zu have %zu\n", off, ws_size);
  int nj = 0, tiles = 0;
  auto job = [&](const float* src, const float* g, bf16_t* dst, int K, int N, int lds, int ldd) {
    TrJob& j = p.jobs[nj++]; j.src = src; j.g = g; j.dst = dst; j.K = K; j.N = N; j.lds = lds; j.ldd = ldd; j.tile0 = tiles; j.ntn = (N + 63) / 64;
    tiles += (K / 64) * j.ntn;
  };
  for (int l = 0; l < NLAYER; ++l) {
    const float* win = in[2] + (size_t)l * 1024 * 6176; const float* gm = in[3] + l * 1024;
    bf16_t* wt = p.Wt_in + (size_t)l * INC * 1024;
    job(win, gm, wt, 1024, 3072, 6176, 1024);
    job(win + 3104, gm, wt + (size_t)3072 * 1024, 1024, 3072, 6176, 1024);
    job(win + 3072, gm, wt + (size_t)6144 * 1024, 1024, 32, 6176, 1024);
    job(in[4] + (size_t)l * 256 * 576, in[5] + l * 256, p.Wt_uq + (size_t)l * 640 * 256, 256, 576, 576, 256);
    job(in[6] + (size_t)l * 128 * 768, in[7] + l * 128, p.Wt_ukv + (size_t)l * 768 * 128, 128, 768, 768, 128);
    bf16_t* wb = p.Wt_br + (size_t)l * 1024 * 1280;
    job(in[13] + (size_t)l * 384 * 1024, nullptr, wb, 384, 1024, 1024, 1280);
    job(in[14] + (size_t)l * 512 * 1024, nullptr, wb + 384, 512, 1024, 1024, 1280);
    job(in[15] + (size_t)l * 384 * 1024, nullptr, wb + 896, 384, 1024, 1024, 1280);
    job(in[16] + (size_t)l * 1024 * 1024, nullptr, p.Wt_out + (size_t)l * 1024 * 1024, 1024, 1024, 1024, 1024);
    job(in[18] + (size_t)l * 1024 * 1024, in[17] + l * 1024, p.Wt_pq + (size_t)l * 1024 * 1024, 1024, 1024, 1024, 1024);
  }
  p.njobs = nj; p.total_tr_tiles = tiles;
  (void)hipMemsetAsync(p.bar, 0, XCD_BAR_WORDS * 4, stream);
  void* args[] = {&p};
  hipError_t e = hipLaunchCooperativeKernel((void*)mega, dim3(grid_blocks), dim3(NTHREADS), args, kDynLds, stream);
  if (e != hipSuccess) fprintf(stderr, "cooperative launch failed: %s (grid %d)\n", hipGetErrorString(e), grid_blocks);
}
```

```cpp
#include <hip/hip_runtime.h>
#include <hip/hip_cooperative_groups.h>
#include <cstdio>
#include <cstdint>
#include <cmath>
#include <cstring>
namespace cg = cooperative_groups;

typedef unsigned short bf16_t;
typedef short bf16x8 __attribute__((ext_vector_type(8)));
typedef float f32x4 __attribute__((ext_vector_type(4)));
typedef unsigned u32x4 __attribute__((ext_vector_type(4)));
typedef unsigned u32x2 __attribute__((ext_vector_type(2)));

constexpr int T_TOK = 16384, SEQ = 8192, DM = 1024, NLAYER = 4;
constexpr int INC = 6272;
constexpr int NTHREADS = 256;
constexpr int SMEM_BYTES = 67712 + 16;
constexpr float LOG2E = 1.4426950408889634f;
constexpr float LN2 = 0.6931471805599453f;

struct TrJob { const float* src; const float* g; bf16_t* dst; int K, N, lds, ldd, tile0, ntn; };

struct Params {
  const float *x, *rel_bias, *lam_q1, *lam_k1, *lam_q2, *lam_k2, *g_subln, *peer_u, *peer_v, *sub_keys, *g_final, *g_ffn;
  float* out;
  float* xcur; bf16_t* xb; bf16_t* qkvA; bf16_t* qkB; bf16_t* vtB; bf16_t* cq_lat; bf16_t* ckv_lat; float* ssq_cq; float* ssq_ckv;
  bf16_t* gates; bf16_t* cq; bf16_t* kC; bf16_t* vtC; bf16_t* oA; bf16_t* oB; float* lseA; bf16_t* y; bf16_t* mix; float* ssq2; bf16_t* pq;
  int* pidx; float* pgate; float* pw; float* ssqn;
  bf16_t *Wt_in, *Wt_uq, *Wt_ukv, *Wt_br, *Wt_out, *Wt_pq, *skeys; unsigned char *pu8, *pv8;
  float *biasA2, *biasB2, *ropec, *ropes, *lam; int* counters; unsigned* bar;
  TrJob jobs[44]; int njobs; int total_tr_tiles;
};

__device__ __forceinline__ unsigned pack2(float lo, float hi) { unsigned r; asm("v_cvt_pk_bf16_f32 %0, %1, %2" : "=v"(r) : "v"(lo), "v"(hi)); return r; }
__device__ __forceinline__ float bflo(unsigned u) { return __uint_as_float(u << 16); }
__device__ __forceinline__ float bfhi(unsigned u) { return __uint_as_float(u & 0xffff0000u); }
__device__ __forceinline__ f32x4 mfma16(bf16x8 a, bf16x8 b, f32x4 c) { return __builtin_amdgcn_mfma_f32_16x16x32_bf16(a, b, c, 0, 0, 0); }
__device__ __forceinline__ float fexp2(float x) { return __builtin_amdgcn_exp2f(x); }
__device__ __forceinline__ int opaque_tid() { int t = threadIdx.x; asm volatile("" : "+v"(t)); return t; }
__device__ __forceinline__ float fmax3(float a, float b, float c) { float r; asm("v_max3_f32 %0, %1, %2, %3" : "=v"(r) : "v"(a), "v"(b), "v"(c)); return r; }
__device__ __forceinline__ unsigned xswap16_max_u(unsigned x) { auto r = __builtin_amdgcn_permlane16_swap(x, x, false, false); return max(r[0], r[1]); }
__device__ __forceinline__ unsigned xswap32_max_u(unsigned x) { auto r = __builtin_amdgcn_permlane32_swap(x, x, false, false); return max(r[0], r[1]); }
__device__ __forceinline__ float xmax_rows(float x) {
  auto r = __builtin_amdgcn_permlane16_swap(__float_as_uint(x), __float_as_uint(x), false, false);
  const float m = fmax3(__uint_as_float(r[0]), __uint_as_float(r[1]), __uint_as_float(r[1]));
  auto q = __builtin_amdgcn_permlane32_swap(__float_as_uint(m), __float_as_uint(m), false, false);
  return fmax3(__uint_as_float(q[0]), __uint_as_float(q[1]), __uint_as_float(q[1]));
}
__device__ __forceinline__ float xsum_rows(float x) {
  auto r = __builtin_amdgcn_permlane16_swap(__float_as_uint(x), __float_as_uint(x), false, false);
  const float m = __uint_as_float(r[0]) + __uint_as_float(r[1]);
  auto q = __builtin_amdgcn_permlane32_swap(__float_as_uint(m), __float_as_uint(m), false, false);
  return __uint_as_float(q[0]) + __uint_as_float(q[1]);
}
__device__ __forceinline__ void lds_barrier() { asm volatile("s_waitcnt lgkmcnt(0)\n\ts_barrier" ::: "memory"); }
__device__ __forceinline__ float wave_sum(float v) {
#pragma unroll
  for (int o = 32; o > 0; o >>= 1) v += __shfl_xor(v, o);
  return v;
}

constexpr int GS = 64, GSTAGE = 128 * GS;
template <bool PF2>
__device__ __forceinline__ void gemm_mainloop_t(const bf16_t* __restrict__ A, int lda, const bf16_t* __restrict__ Bt, int ldb, int K,
                                                bf16_t* smem, f32x4 (&acc)[4][4], const int tid) {
  const int lane = tid & 63, w = tid >> 6, wm = w >> 1, wn = w & 1, fr = lane & 15, fq = lane >> 4;
  const int lr = tid >> 3, lc = (tid & 7) * 8, lcs = ((tid & 7) ^ (lr & 7)) * 8;
  const bf16_t* ag = A + (size_t)lr * lda + lc;
  const bf16_t* bg = Bt + (size_t)lr * ldb + lc;
  u32x4 ra[PF2 ? 2 : 1][4], rb[PF2 ? 2 : 1][4];
  const int nk = K >> 6;
  auto gload = [&](int set, int kt) {
    const int k0 = kt << 6;
#pragma unroll
    for (int i = 0; i < 4; ++i) { ra[set][i] = *(const u32x4*)(ag + (size_t)(32 * i) * lda + k0); rb[set][i] = *(const u32x4*)(bg + (size_t)(32 * i) * ldb + k0); }
  };
  auto sstore = [&](int set, int st) {
    bf16_t* ds = smem + st * 2 * GSTAGE;
#pragma unroll
    for (int i = 0; i < 4; ++i) { *(u32x4*)(ds + (lr + 32 * i) * GS + lcs) = ra[set][i]; *(u32x4*)(ds + GSTAGE + (lr + 32 * i) * GS + lcs) = rb[set][i]; }
  };
  auto compute = [&](int st) {
    const bf16_t* as = smem + st * 2 * GSTAGE;
    const bf16_t* bs = as + GSTAGE;
#pragma unroll
    for (int ks = 0; ks < 2; ++ks) {
      bf16x8 af[4], bfr[4];
#pragma unroll
      for (int mi = 0; mi < 4; ++mi) af[mi] = *(const bf16x8*)(as + (wm * 64 + mi * 16 + fr) * GS + (((ks * 4 + fq) ^ (fr & 7)) * 8));
#pragma unroll
      for (int ni = 0; ni < 4; ++ni) bfr[ni] = *(const bf16x8*)(bs + (wn * 64 + ni * 16 + fr) * GS + (((ks * 4 + fq) ^ (fr & 7)) * 8));
#pragma unroll
      for (int mi = 0; mi < 4; ++mi)
#pragma unroll
        for (int ni = 0; ni < 4; ++ni) acc[mi][ni] = mfma16(bfr[ni], af[mi], acc[mi][ni]);
    }
  };
  if (PF2) {
    gload(0, 0);
    gload(1, 1);
    sstore(0, 0);
    lds_barrier();
    for (int kt = 0; kt < nk; kt += 2) {
      gload(0, min(kt + 2, nk - 1));
      __builtin_amdgcn_sched_barrier(0);
      compute(0);
      sstore(1, 1);
      lds_barrier();
      gload(1, min(kt + 3, nk - 1));
      __builtin_amdgcn_sched_barrier(0);
      compute(1);
      sstore(0, 0);
      lds_barrier();
    }
  } else {
    gload(0, 0); sstore(0, 0);
    lds_barrier();
    for (int kt = 0; kt < nk; ++kt) {
      gload(0, min(kt + 1, nk - 1));
      __builtin_amdgcn_sched_barrier(0);
      compute(kt & 1);
      __builtin_amdgcn_sched_barrier(0);
      sstore(0, (kt + 1) & 1);
      lds_barrier();
    }
  }
}
#ifndef GEMM_PF2
#define GEMM_PF2 true
#endif
__device__ __forceinline__ void gemm_mainloop(const bf16_t* __restrict__ A, int lda, const bf16_t* __restrict__ Bt, int ldb, int K,
                                              bf16_t* smem, f32x4 (&acc)[4][4], const int tid) {
  gemm_mainloop_t<GEMM_PF2>(A, lda, Bt, ldb, K, smem, acc, tid);
}

__device__ __forceinline__ void zero_acc(f32x4 (&acc)[4][4]) {
#pragma unroll
  for (int i = 0; i < 4; ++i)
#pragma unroll
    for (int j = 0; j < 4; ++j) acc[i][j] = (f32x4){0.f, 0.f, 0.f, 0.f};
}

__device__ __forceinline__ bool xcd_tile(int iter, int MT, int NT, int& m, int& n) {
  const int xcd = blockIdx.x & 7, slot = blockIdx.x >> 3, per = gridDim.x >> 3;
  const int mper = MT >> 3;
  const int li = iter * per + slot;
  if (li >= mper * NT) return false;
  const int mg = li / (NT * 8), rem = li % (NT * 8);
  n = rem >> 3;
  int mi = (rem & 7) + mg * 8;
  m = xcd * mper + mi;
  return true;
}

__device__ __forceinline__ void store4bf(bf16_t* p, f32x4 v) { u32x2 o; o.x = pack2(v[0], v[1]); o.y = pack2(v[2], v[3]); *(u32x2*)p = o; }

__device__ __forceinline__ void peer_convert_chunk(const Params& p, int l, size_t i) {
  const size_t base = (size_t)l * 16384 * 1024 + i * 16;
  u32x4 ou, ov;
#pragma unroll
  for (int c = 0; c < 4; ++c) {
    const f32x4 a = *(const f32x4*)(p.peer_u + base + c * 4) * 256.f;
    int r = 0; r = __builtin_amdgcn_cvt_pk_fp8_f32(a[0], a[1], r, false); r = __builtin_amdgcn_cvt_pk_fp8_f32(a[2], a[3], r, true); ou[c] = (unsigned)r;
    const f32x4 d = *(const f32x4*)(p.peer_v + base + c * 4) * 64.f;
    int q = 0; q = __builtin_amdgcn_cvt_pk_fp8_f32(d[0], d[1], q, false); q = __builtin_amdgcn_cvt_pk_fp8_f32(d[2], d[3], q, true); ov[c] = (unsigned)q;
  }
  *(u32x4*)(p.pu8 + base) = ou;
  *(u32x4*)(p.pv8 + base) = ov;
}

__device__ void phase_inproj(const Params& p, int l, unsigned char* smem) {
  const int tid = opaque_tid(), lane = tid & 63, w = tid >> 6, wm = w >> 1, wn = w & 1, fr = lane & 15, fq = lane >> 4;
  const bf16_t* W = p.Wt_in + (size_t)l * INC * DM;
  int mt, ct;
  constexpr size_t N16L = (size_t)16384 * 1024 / 16;
  int it = 0;
  for (; xcd_tile(it, 128, 49, mt, ct); ++it) {
    f32x4 acc[4][4]; zero_acc(acc);
    gemm_mainloop(p.xb + (size_t)mt * 128 * DM, DM, W + (size_t)ct * 128 * DM, DM, DM, (bf16_t*)smem, acc, tid);
    const int rowb = mt * 128 + wm * 64 + fr;
    const int colb = ct * 128 + wn * 64 + fq * 4;
#pragma unroll
    for (int mi = 0; mi < 4; ++mi) {
      const f32x4 s0 = *(const f32x4*)(p.ssqn + (rowb + mi * 16) * 8), s1 = *(const f32x4*)(p.ssqn + (rowb + mi * 16) * 8 + 4);
      const float rstd = rsqrtf(((s0[0] + s0[1]) + (s0[2] + s0[3]) + (s1[0] + s1[1]) + (s1[2] + s1[3])) * (1.f / 1024.f) + 1e-6f);
#pragma unroll
      for (int ni = 0; ni < 4; ++ni) acc[mi][ni] *= rstd;
    }
    if (ct < 9) {
#pragma unroll
      for (int mi = 0; mi < 4; ++mi)
#pragma unroll
        for (int ni = 0; ni < 4; ++ni) store4bf(p.qkvA + (size_t)(rowb + mi * 16) * 1152 + colb + ni * 16, acc[mi][ni]);
    } else if (ct < 17) {
#pragma unroll
      for (int mi = 0; mi < 4; ++mi)
#pragma unroll
        for (int ni = 0; ni < 4; ++ni) store4bf(p.qkB + (size_t)(rowb + mi * 16) * 1024 + (colb - 1152) + ni * 16, acc[mi][ni]);
    } else if (ct < 21) {
      const int h = ct - 17;
#pragma unroll
      for (int mi = 0; mi < 4; ++mi) {
        const int row = rowb + mi * 16, b = row >> 13, pos = row & 8191;
#pragma unroll
        for (int ni = 0; ni < 4; ++ni) {
          const int dv = wn * 64 + ni * 16 + fq * 4;
          bf16_t* d = p.vtB + ((size_t)((b * 4 + h) * 128 + dv)) * SEQ + pos;
          const unsigned u0 = pack2(acc[mi][ni][0], acc[mi][ni][1]), u1 = pack2(acc[mi][ni][2], acc[mi][ni][3]);
          d[0] = (bf16_t)u0; d[SEQ] = (bf16_t)(u0 >> 16); d[2 * SEQ] = (bf16_t)u1; d[3 * SEQ] = (bf16_t)(u1 >> 16);
        }
      }
    } else if (ct < 24) {
#pragma unroll
      for (int mi = 0; mi < 4; ++mi) {
        const int row = rowb + mi * 16;
        float s = 0.f;
#pragma unroll
        for (int ni = 0; ni < 4; ++ni) {
          const f32x4 v = acc[mi][ni];
          s += v[0] * v[0] + v[1] * v[1] + v[2] * v[2] + v[3] * v[3];
          if (ct < 23) store4bf(p.cq_lat + (size_t)row * 256 + (colb - 2688) + ni * 16, v);
          else store4bf(p.ckv_lat + (size_t)row * 128 + (colb - 2944) + ni * 16, v);
        }
        s = xsum_rows(s);
        if (fq == 0) { if (ct < 23) p.ssq_cq[row * 4 + (ct - 21) * 2 + wn] = s; else p.ssq_ckv[row * 2 + wn] = s; }
      }
    } else if (ct < 48) {
#pragma unroll
      for (int mi = 0; mi < 4; ++mi)
#pragma unroll
        for (int ni = 0; ni < 4; ++ni) {
          f32x4 v = acc[mi][ni];
#pragma unroll
          for (int r = 0; r < 4; ++r) v[r] = 1.f / (1.f + __expf(-v[r]));
          store4bf(p.gates + (size_t)(rowb + mi * 16) * 3072 + (colb - 3072) + ni * 16, v);
        }
    } else {
      if (wn == 0) {
#pragma unroll
        for (int mi = 0; mi < 4; ++mi) {
          const int row = rowb + mi * 16, pos = row & 8191;
          const f32x4 c = *(const f32x4*)(p.ropec + pos * 16 + fq * 4), s = *(const f32x4*)(p.ropes + pos * 16 + fq * 4);
          const f32x4 x1 = acc[mi][0], x2 = acc[mi][1];
          const f32x4 o1 = x1 * c - x2 * s, o2 = x1 * s + x2 * c;
#pragma unroll
          for (int h = 0; h < 6; ++h) {
            store4bf(p.kC + (size_t)row * 576 + h * 96 + 64 + fq * 4, o1);
            store4bf(p.kC + (size_t)row * 576 + h * 96 + 80 + fq * 4, o2);
          }
        }
      }
    }
    {
      const size_t ci = ((size_t)it * gridDim.x + blockIdx.x) * NTHREADS + tid;
      if (ci < N16L) peer_convert_chunk(p, l, ci);
    }
  }
  for (;; ++it) {
    const size_t ci = ((size_t)it * gridDim.x + blockIdx.x) * NTHREADS + tid;
    if ((size_t)it * gridDim.x * NTHREADS >= N16L) break;
    if (ci < N16L) peer_convert_chunk(p, l, ci);
  }
}

__device__ void phase_cup(const Params& p, int l, unsigned char* smem) {
  const int tid = opaque_tid(), lane = tid & 63, w = tid >> 6, wm = w >> 1, wn = w & 1, fr = lane & 15, fq = lane >> 4;
  int mt, ct;
  for (int it = 0; xcd_tile(it, 128, 11, mt, ct); ++it) {
    f32x4 acc[4][4]; zero_acc(acc);
    const int rowb = mt * 128 + wm * 64 + fr;
    if (ct < 5) {
      gemm_mainloop(p.cq_lat + (size_t)mt * 128 * 256, 256, p.Wt_uq + ((size_t)l * 640 + ct * 128) * 256, 256, 256, (bf16_t*)smem, acc, tid);
      const int c0 = ct * 128 + wn * 64;
#pragma unroll
      for (int mi = 0; mi < 4; ++mi) {
        const int row = rowb + mi * 16, pos = row & 8191;
        const f32x4 sq = *(const f32x4*)(p.ssq_cq + row * 4);
        const float rstd = rsqrtf((sq[0] + sq[1] + sq[2] + sq[3]) * (1.f / 256.f) + 1e-6f);
#pragma unroll
        for (int ni = 0; ni < 4; ++ni) {
          const int t16 = (c0 >> 4) + ni, col = c0 + ni * 16 + fq * 4;
          if (t16 >= 36) continue;
          const int ph = t16 % 6;
          if (ph < 4) store4bf(p.cq + (size_t)row * 576 + col, acc[mi][ni] * rstd);
          else if (ph == 4) {
            if (ni < 3) {
              const f32x4 c = *(const f32x4*)(p.ropec + pos * 16 + fq * 4), s = *(const f32x4*)(p.ropes + pos * 16 + fq * 4);
              const f32x4 x1 = acc[mi][ni] * rstd, x2 = acc[mi][ni + 1 > 3 ? 3 : ni + 1] * rstd;
              store4bf(p.cq + (size_t)row * 576 + col, x1 * c - x2 * s);
              store4bf(p.cq + (size_t)row * 576 + col + 16, x1 * s + x2 * c);
            }
          }
        }
      }
    } else {
      const int c2 = ct - 5;
      gemm_mainloop(p.ckv_lat + (size_t)mt * 128 * 128, 128, p.Wt_ukv + ((size_t)l * 768 + c2 * 128) * 128, 128, 128, (bf16_t*)smem, acc, tid);
      const int h = c2;
#pragma unroll
      for (int mi = 0; mi < 4; ++mi) {
        const int row = rowb + mi * 16, b = row >> 13, pos = row & 8191;
        const float rstd = rsqrtf((p.ssq_ckv[row * 2] + p.ssq_ckv[row * 2 + 1]) * (1.f / 128.f) + 1e-6f);
#pragma unroll
        for (int ni = 0; ni < 4; ++ni) {
          const f32x4 v = acc[mi][ni] * rstd;
          if (wn == 0) store4bf(p.kC + (size_t)row * 576 + h * 96 + ni * 16 + fq * 4, v);
          else {
            const int dv = ni * 16 + fq * 4;
            bf16_t* d = p.vtC + ((size_t)((b * 6 + h) * 64 + dv)) * SEQ + pos;
            const unsigned u0 = pack2(v[0], v[1]), u1 = pack2(v[2], v[3]);
            d[0] = (bf16_t)u0; d[SEQ] = (bf16_t)(u0 >> 16); d[2 * SEQ] = (bf16_t)u1; d[3 * SEQ] = (bf16_t)(u1 >> 16);
          }
        }
      }
    }
  }
}

__device__ void phase_branch(const Params& p, int l, unsigned char* smem) {
  const int tid = opaque_tid(), lane = tid & 63, w = tid >> 6, wm = w >> 1, wn = w & 1, fr = lane & 15, fq = lane >> 4;
  const bf16_t* W = p.Wt_br + (size_t)l * 1024 * 1280;
  int mt, ct;
  for (int it = 0; xcd_tile(it, 128, 8, mt, ct); ++it) {
    unsigned tot[4][4][2];
    const int rowb = mt * 128 + wm * 64 + fr, colb = ct * 128 + wn * 64 + fq * 4;
#pragma unroll 1
    for (int seg = 0; seg < 3; ++seg) {
      const int koff = seg == 0 ? 0 : (seg == 1 ? 384 : 896), kk = seg == 1 ? 512 : 384;
      f32x4 acc[4][4]; zero_acc(acc);
      gemm_mainloop_t<false>(p.y + (size_t)mt * 128 * 1280 + koff, 1280, W + (size_t)ct * 128 * 1280 + koff, 1280, kk, (bf16_t*)smem, acc, tid);
      u32x2 gg[4][4];
#pragma unroll
      for (int mi = 0; mi < 4; ++mi)
#pragma unroll
        for (int ni = 0; ni < 4; ++ni) gg[mi][ni] = *(const u32x2*)(p.gates + (size_t)(rowb + mi * 16) * 3072 + seg * 1024 + colb + ni * 16);
#pragma unroll
      for (int mi = 0; mi < 4; ++mi)
#pragma unroll
        for (int ni = 0; ni < 4; ++ni) {
          const u32x2 g = gg[mi][ni];
          float t0 = bflo(g.x) * acc[mi][ni][0], t1 = bfhi(g.x) * acc[mi][ni][1], t2 = bflo(g.y) * acc[mi][ni][2], t3 = bfhi(g.y) * acc[mi][ni][3];
          if (seg > 0) { t0 += bflo(tot[mi][ni][0]); t1 += bfhi(tot[mi][ni][0]); t2 += bflo(tot[mi][ni][1]); t3 += bfhi(tot[mi][ni][1]); }
          tot[mi][ni][0] = pack2(t0, t1); tot[mi][ni][1] = pack2(t2, t3);
        }
    }
#pragma unroll
    for (int mi = 0; mi < 4; ++mi)
#pragma unroll
      for (int ni = 0; ni < 4; ++ni) *(u32x2*)(p.mix + (size_t)(rowb + mi * 16) * 1024 + colb + ni * 16) = (u32x2){tot[mi][ni][0], tot[mi][ni][1]};
  }
}

__device__ void phase_wout(const Params& p, int l, unsigned char* smem) {
  const int tid = opaque_tid(), lane = tid & 63, w = tid >> 6, wm = w >> 1, wn = w & 1, fr = lane & 15, fq = lane >> 4;
  const bf16_t* W = p.Wt_out + (size_t)l * 1024 * 1024;
  int mt, ct;
  for (int it = 0; xcd_tile(it, 128, 8, mt, ct); ++it) {
    f32x4 acc[4][4]; zero_acc(acc);
    gemm_mainloop(p.mix + (size_t)mt * 128 * 1024, 1024, W + (size_t)ct * 128 * 1024, 1024, 1024, (bf16_t*)smem, acc, tid);
    const int rowb = mt * 128 + wm * 64 + fr, colb = ct * 128 + wn * 64 + fq * 4;
    f32x4 xin[4][4];
#pragma unroll
    for (int mi = 0; mi < 4; ++mi)
#pragma unroll
      for (int ni = 0; ni < 4; ++ni) xin[mi][ni] = *(const f32x4*)((l == 0 ? p.x : p.xcur) + (size_t)(rowb + mi * 16) * 1024 + colb + ni * 16);
#pragma unroll
    for (int mi = 0; mi < 4; ++mi) {
      const int row = rowb + mi * 16;
      float s = 0.f;
#pragma unroll
      for (int ni = 0; ni < 4; ++ni) {
        const f32x4 v = xin[mi][ni] + acc[mi][ni];
        *(f32x4*)(p.xcur + (size_t)row * 1024 + colb + ni * 16) = v;
        store4bf(p.xb + (size_t)row * 1024 + colb + ni * 16, v);
        s += v[0] * v[0] + v[1] * v[1] + v[2] * v[2] + v[3] * v[3];
      }
      s = xsum_rows(s);
      if (fq == 0) p.ssq2[row * 16 + ct * 2 + wn] = s;
    }
  }
}

__device__ void phase_pq(const Params& p, int l, unsigned char* smem) {
  const int tid = opaque_tid(), lane = tid & 63, w = tid >> 6, wm = w >> 1, wn = w & 1, fr = lane & 15, fq = lane >> 4;
  const bf16_t* W = p.Wt_pq + (size_t)l * 1024 * 1024;
  int mt, ct;
  for (int it = 0; xcd_tile(it, 128, 8, mt, ct); ++it) {
    f32x4 acc[4][4]; zero_acc(acc);
    gemm_mainloop(p.xb + (size_t)mt * 128 * 1024, 1024, W + (size_t)ct * 128 * 1024, 1024, 1024, (bf16_t*)smem, acc, tid);
    const int rowb = mt * 128 + wm * 64 + fr, colb = ct * 128 + wn * 64 + fq * 4;
    f32x4 sq[4][4];
#pragma unroll
    for (int mi = 0; mi < 4; ++mi)
#pragma unroll
      for (int i = 0; i < 4; ++i) sq[mi][i] = *(const f32x4*)(p.ssq2 + (rowb + mi * 16) * 16 + i * 4);
#pragma unroll
    for (int mi = 0; mi < 4; ++mi) {
      const int row = rowb + mi * 16;
      float s = 0.f;
#pragma unroll
      for (int i = 0; i < 4; ++i) s += sq[mi][i][0] + sq[mi][i][1] + sq[mi][i][2] + sq[mi][i][3];
      const float rstd = rsqrtf(s * (1.f / 1024.f) + 1e-6f);
#pragma unroll
      for (int ni = 0; ni < 4; ++ni) store4bf(p.pq + (size_t)row * 1024 + colb + ni * 16, acc[mi][ni] * rstd);
    }
  }
}

#ifndef ATT_SB
#define ATT_SB 1
#endif
#if ATT_SB
#define ATT_SCHED_BARRIER __builtin_amdgcn_sched_barrier(0)
#else
#define ATT_SCHED_BARRIER
#endif
#ifndef ATT_PVB
#define ATT_PVB 4
#endif
#ifndef ATT_QG_B
#define ATT_QG_B 2
#endif
constexpr int VTS = 80;
constexpr int ATT_K_OFF = 0, ATT_V_OFF = 14336, ATT_BIAS_OFF = 14336 + 20480, ATT_MISC_OFF = ATT_BIAS_OFF + 8192, ATT_Q_OFF = ATT_MISC_OFF + 64;

template <int DQK, int DV, int MODE>
__device__ __forceinline__ void flash_block(const bf16_t* __restrict__ Qp, int qrs, const bf16_t* __restrict__ Kp, int krs,
                                            const bf16_t* __restrict__ Vp, int vrs, int kt_begin, int kt_end, int qpos0, int jmin,
                                            float c1, unsigned char* smem, f32x4 (&O)[2][DV / 16], float (&mrow)[2], float (&lrow)[2], const int tid) {
  constexpr int KST = DQK + 16, KCH = DQK / 8, NKC = 64 * KCH / 256, NVC = (MODE == 0) ? 2 : DV * 8 / 256, NDT = DV / 16, NKS = DQK / 32;
  const int lane = tid & 63, w = tid >> 6, fr = lane & 15, fq = lane >> 4;
  bf16_t* Ks = (bf16_t*)(smem + ATT_K_OFF);
  bf16_t* Vt = (bf16_t*)(smem + ATT_V_OFF);
  const float* bias_lds = (const float*)(smem + ATT_BIAS_OFF);
  bf16_t* Qs = (bf16_t*)(smem + ATT_Q_OFF) + (w * 2 * NKS) * 512 + lane * 8;
#pragma unroll
  for (int qi = 0; qi < 2; ++qi)
#pragma unroll
    for (int ks = 0; ks < NKS; ++ks)
      *(bf16x8*)(Qs + (qi * NKS + ks) * 512) = *(const bf16x8*)(Qp + (unsigned)((w * 32 + qi * 16 + fr) * qrs + ks * 32 + fq * 8));
#pragma unroll
  for (int qi = 0; qi < 2; ++qi) {
    mrow[qi] = -1e30f; lrow[qi] = 0.f;
#pragma unroll
    for (int dt = 0; dt < NDT; ++dt) O[qi][dt] = (f32x4){0.f, 0.f, 0.f, 0.f};
  }
  int wkb, wke;
  if (MODE == 0) { wkb = max(kt_begin, w >> 1); wke = (w * 32 + 159) / 64 + 1; }
  else { wkb = 0; wke = (qpos0 + w * 32 + 31) / 64 + 1; }
  u32x4 rk[NKC], rv[NVC];
  auto gload = [&](int kt) {
#pragma unroll
    for (int i = 0; i < NKC; ++i) { const int c = tid + 256 * i, key = c / KCH, part = c % KCH; rk[i] = *(const u32x4*)(Kp + (unsigned)((kt * 64 + key) * krs + part * 8)); }
    if (MODE == 0) {
#pragma unroll
      for (int i = 0; i < NVC; ++i) { const int c = tid + 256 * i, key = c >> 3, part = c & 7; rv[i] = *(const u32x4*)(Vp + (unsigned)((kt * 64 + key) * vrs + part * 8)); }
    } else {
#pragma unroll
      for (int i = 0; i < NVC; ++i) { const int c = tid + 256 * i, dv = c >> 3, kc = c & 7; rv[i] = *(const u32x4*)(Vp + (unsigned)(dv * vrs + kt * 64 + kc * 8)); }
    }
  };
  auto sstore = [&]() {
#pragma unroll
    for (int i = 0; i < NKC; ++i) { const int c = tid + 256 * i, key = c / KCH, part = c % KCH; *(u32x4*)(Ks + key * KST + part * 8) = rk[i]; }
    if (MODE == 0) {
#pragma unroll
      for (int i = 0; i < NVC; ++i) {
        const int c = tid + 256 * i, key = c >> 3, part = c & 7;
        const int pos = (key & 32) + ((key >> 2) & 3) * 8 + ((key >> 4) & 1) * 4 + (key & 3);
#pragma unroll
        for (int e = 0; e < 8; ++e) Vt[(part * 8 + e) * VTS + pos] = (bf16_t)(rv[i][e >> 1] >> ((e & 1) * 16));
      }
    } else {
#pragma unroll
      for (int i = 0; i < NVC; ++i) {
        const int c = tid + 256 * i, dv = c >> 3, kc = c & 7;
        const int pos0 = (kc >> 2) * 32 + ((kc & 1) * 2) * 8 + ((kc >> 1) & 1) * 4;
        *(u32x2*)(Vt + dv * VTS + pos0) = (u32x2){rv[i].x, rv[i].y};
        *(u32x2*)(Vt + dv * VTS + pos0 + 8) = (u32x2){rv[i].z, rv[i].w};
      }
    }
  };
  gload(kt_begin);
  __syncthreads();
  sstore();
  __syncthreads();
  for (int kt = kt_begin; kt < kt_end; ++kt) {
    const bool more = kt + 1 < kt_end;
    if (more) gload(kt + 1);
    ATT_SCHED_BARRIER;
    bf16_t* Qs2 = Qs; asm volatile("" : "+v"(Qs2));
    if (kt >= wkb && kt < wke) {
      int path = 1; float cb = 0.f; bool need_mask = true;
      if (MODE == 2) { need_mask = (kt * 64 + 63) > (qpos0 + w * 32); path = need_mask ? 1 : 0; }
      if (MODE == 1) {
        need_mask = (kt * 64 + 63) > (qpos0 + w * 32);
        const int dmin = (qpos0 + w * 32) - (kt * 64 + 63);
        if (dmin >= 0) {
          const float blo = bias_lds[min(dmin, 2047)], bhi = bias_lds[min(dmin + 94, 2047)];
          if (((__float_as_uint(blo) ^ __float_as_uint(bhi)) & 31u) == 0u) { path = 0; cb = blo; }
        }
      }
      constexpr int QG = (DV == 128) ? ATT_QG_B : 2;
#pragma unroll
      for (int q0 = 0; q0 < 2; q0 += QG) {
        f32x4 S[QG][4];
#pragma unroll
        for (int t = 0; t < 4; ++t) {
          {
            const bf16x8 kf = *(const bf16x8*)(Ks + (t * 16 + fr) * KST + fq * 8);
#pragma unroll
            for (int qq = 0; qq < QG; ++qq) S[qq][t] = __builtin_amdgcn_mfma_f32_16x16x32_bf16(kf, *(const bf16x8*)(Qs2 + ((q0 + qq) * NKS) * 512), (f32x4){0.f, 0.f, 0.f, 0.f}, 0, 0, 0);
          }
#pragma unroll
          for (int ks = 1; ks < NKS; ++ks) {
            const bf16x8 kf = *(const bf16x8*)(Ks + (t * 16 + fr) * KST + ks * 32 + fq * 8);
#pragma unroll
            for (int qq = 0; qq < QG; ++qq) S[qq][t] = mfma16(kf, *(const bf16x8*)(Qs2 + ((q0 + qq) * NKS + ks) * 512), S[qq][t]);
          }
        }
        ATT_SCHED_BARRIER;
        bf16x8 pf[QG][2];
#pragma unroll
        for (int qq = 0; qq < QG; ++qq) {
          const int qi = q0 + qq;
          const int qrow = w * 32 + qi * 16 + fr;
          f32x4 P[4];
          float mn;
          if (path == 0) {
            float mx = fmax3(S[qq][0][0], S[qq][0][1], S[qq][0][2]);
            mx = fmax3(mx, S[qq][0][3], S[qq][1][0]); mx = fmax3(mx, S[qq][1][1], S[qq][1][2]); mx = fmax3(mx, S[qq][1][3], S[qq][2][0]);
            mx = fmax3(mx, S[qq][2][1], S[qq][2][2]); mx = fmax3(mx, S[qq][2][3], S[qq][3][0]); mx = fmax3(mx, S[qq][3][1], S[qq][3][2]);
            mx = fmax3(mx, S[qq][3][3], mx);
            mx = xmax_rows(mx);
            mn = fmax3(mrow[qi], mx * c1 + cb, mrow[qi]);
            const float off = cb - mn;
#pragma unroll
            for (int t = 0; t < 4; ++t) P[t] = S[qq][t] * c1 + off;
          } else {
            float mx = -1e30f;
#pragma unroll
            for (int t = 0; t < 4; ++t)
#pragma unroll
              for (int r = 0; r < 4; ++r) {
                const int j = kt * 64 + t * 16 + fq * 4 + r;
                float sx = S[qq][t][r] * c1;
                if (MODE == 1) {
                  const int dist = qpos0 + qrow - j;
                  sx += bias_lds[min(max(dist, 0), 2047)];
                  if (need_mask && dist < 0) sx = -1e30f;
                } else if (MODE == 2) {
                  if ((qpos0 + qrow - j) < 0) sx = -1e30f;
                } else {
                  const int rel = 128 + qrow - j;
                  sx += bias_lds[min(max(rel, 0), 128)];
                  if (rel < 0 || rel > 128 || j < jmin) sx = -1e30f;
                }
                P[t][r] = sx;
              }
#pragma unroll
            for (int t = 0; t < 4; ++t) { mx = fmax3(mx, P[t][0], P[t][1]); mx = fmax3(mx, P[t][2], P[t][3]); }
            mx = xmax_rows(mx);
            mn = fmax3(mrow[qi], mx, mx);
#pragma unroll
            for (int t = 0; t < 4; ++t) P[t] = P[t] - mn;
          }
          {
            const float alpha = fexp2(mrow[qi] - mn);
            lrow[qi] *= alpha;
#pragma unroll
            for (int dt = 0; dt < NDT; ++dt) O[qi][dt] *= alpha;
          }
          mrow[qi] = mn;
          f32x4 ls4 = (f32x4){0.f, 0.f, 0.f, 0.f};
#pragma unroll
          for (int t = 0; t < 4; ++t) {
#pragma unroll
            for (int r = 0; r < 4; ++r) P[t][r] = fexp2(P[t][r]);
            ls4 += P[t];
          }
          lrow[qi] += (ls4[0] + ls4[1]) + (ls4[2] + ls4[3]);
#pragma unroll
          for (int s2 = 0; s2 < 2; ++s2) {
            u32x4 pk;
            pk.x = pack2(P[2 * s2][0], P[2 * s2][1]); pk.y = pack2(P[2 * s2][2], P[2 * s2][3]);
            pk.z = pack2(P[2 * s2 + 1][0], P[2 * s2 + 1][1]); pk.w = pack2(P[2 * s2 + 1][2], P[2 * s2 + 1][3]);
            pf[qq][s2] = __builtin_bit_cast(bf16x8, pk);
          }
          ATT_SCHED_BARRIER;
        }
#pragma unroll
        for (int s2 = 0; s2 < 2; ++s2)
#pragma unroll
          for (int dt = 0; dt < NDT; ++dt) {
            const bf16x8 vf = *(const bf16x8*)(Vt + (dt * 16 + fr) * VTS + s2 * 32 + fq * 8);
#pragma unroll
            for (int qq = 0; qq < QG; ++qq) O[q0 + qq][dt] = mfma16(vf, pf[qq][s2], O[q0 + qq][dt]);
            if ((dt & (ATT_PVB - 1)) == (ATT_PVB - 1)) ATT_SCHED_BARRIER;
          }
      }
    }
    lds_barrier();
    if (more) { sstore(); lds_barrier(); }
  }
#pragma unroll
  for (int qi = 0; qi < 2; ++qi) lrow[qi] = xsum_rows(lrow[qi]);
}

__device__ __forceinline__ int next_item(int* counter, int* s_item, const int tid) {
  __syncthreads();
  if (tid == 0) *s_item = atomicAdd(counter, 1);
  __syncthreads();
  return *s_item;
}

__device__ void phase_attn(const Params& p, int l, unsigned char* smem, int cset = 0) {
  const int tid = opaque_tid(), lane = tid & 63, w = tid >> 6, fr = lane & 15, fq = lane >> 4;
  int* s_item = (int*)(smem + ATT_MISC_OFF);
  float* bias_lds = (float*)(smem + ATT_BIAS_OFF);
  const int xcd = blockIdx.x & 7;
#pragma unroll 1
  for (;;) {
    const int item = next_item(p.counters + ((cset * 4 + l) * 3 + 0) * 8 + xcd, s_item, tid);
    if (item >= 128) break;
    const int qb = 63 - (item >> 1), mp = item & 1;
    const int b = xcd >> 2, h = xcd & 3;
    for (int i = tid; i < 2048; i += NTHREADS) bias_lds[i] = p.biasB2[h * 2048 + i];
    const long tok0 = (long)b * SEQ + qb * 128;
    const bf16_t* Vp = p.vtB + (size_t)((b * 4 + h) * 128) * SEQ;
    const int kt_end = (qb * 128 + 127) / 64 + 1;
    f32x4 O[2][8]; float mr[2], lr[2];
    flash_block<64, 128, 1>(p.qkB + tok0 * 1024 + h * 128 + mp * 64, 1024, p.qkB + (long)b * SEQ * 1024 + 512 + h * 128 + mp * 64, 1024, Vp, SEQ, 0, kt_end,
                            qb * 128, 0, 0.125f * LOG2E, smem, O, mr, lr, tid);
#pragma unroll
    for (int qi = 0; qi < 2; ++qi) {
      const float inv = 1.f / lr[qi];
      const long tok = tok0 + w * 32 + qi * 16 + fr;
#pragma unroll
      for (int dt = 0; dt < 8; ++dt) store4bf(p.oB + ((size_t)mp * T_TOK + tok) * 512 + h * 128 + dt * 16 + fq * 4, O[qi][dt] * inv);
    }
  }
#pragma unroll 1
  for (;;) {
    const int item = next_item(p.counters + ((cset * 4 + l) * 3 + 1) * 8 + xcd, s_item, tid);
    if (item >= 96) break;
    const int lvl = item / 3, sel = item % 3;
    int bh, qb;
    if (sel < 2) { bh = xcd; qb = 63 - 2 * lvl - sel; } else { bh = 8 + (xcd >> 1); qb = 63 - 2 * lvl - (xcd & 1); }
    const int b = bh / 6, h = bh % 6;
    const long tok0 = (long)b * SEQ + qb * 128;
    const int kt_end = (qb * 128 + 127) / 64 + 1;
    f32x4 O[2][4]; float mr[2], lr[2];
    flash_block<96, 64, 2>(p.cq + tok0 * 576 + h * 96, 576, p.kC + (long)b * SEQ * 576 + h * 96, 576, p.vtC + (size_t)((b * 6 + h) * 64) * SEQ, SEQ,
                           0, kt_end, qb * 128, 0, 0.10206207261596575f * LOG2E, smem, O, mr, lr, tid);
#pragma unroll
    for (int qi = 0; qi < 2; ++qi) {
      const float inv = 1.f / lr[qi];
      const long tok = tok0 + w * 32 + qi * 16 + fr;
#pragma unroll
      for (int dt = 0; dt < 4; ++dt) store4bf(p.y + tok * 1280 + 896 + h * 64 + dt * 16 + fq * 4, O[qi][dt] * inv);
    }
  }
#pragma unroll 1
  for (;;) {
    const int a = next_item(p.counters + ((cset * 4 + l) * 3 + 2) * 8, s_item, tid);
    if (a >= 2304) break;
    const int g = a / 768, rem = a % 768, b = rem / 384, h = (rem >> 6) % 6, blk = rem & 63;
    const int d = g == 0 ? 1 : (g == 1 ? 4 : 16);
    const int r = blk % d, n = blk / d;
    for (int i = tid; i < 129; i += NTHREADS) bias_lds[i] = p.biasA2[(g * 6 + h) * 129 + i];
    const long row_q0 = (long)b * SEQ + (long)n * 128 * d + r;
    const long row_k0 = row_q0 - 128L * d;
    f32x4 O[2][4]; float mr[2], lr[2];
    flash_block<64, 64, 0>(p.qkvA + row_q0 * 1152 + h * 64, 1152 * d, p.qkvA + row_k0 * 1152 + 384 + h * 64, 1152 * d,
                           p.qkvA + row_k0 * 1152 + 768 + h * 64, 1152 * d, n == 0 ? 2 : 0, 4, 0, n == 0 ? 128 : 0, 0.125f * LOG2E, smem, O, mr, lr, tid);
#pragma unroll
    for (int qi = 0; qi < 2; ++qi) {
      const float inv = 1.f / lr[qi];
      const long tok = row_q0 + (long)(w * 32 + qi * 16 + fr) * d;
#pragma unroll
      for (int dt = 0; dt < 4; ++dt) store4bf(p.oA + ((size_t)g * T_TOK + tok) * 384 + h * 64 + dt * 16 + fq * 4, O[qi][dt] * inv);
      if (fq == 0) p.lseA[((size_t)g * T_TOK + tok) * 6 + h] = (mr[qi] + __log2f(lr[qi])) * LN2;
    }
  }
}

__device__ void phase_mergeA(const Params& p, int l) {
  const int tid = opaque_tid();
  const int total = T_TOK * 6 * 8;
  for (int i = blockIdx.x * NTHREADS + tid; i < total; i += gridDim.x * NTHREADS) {
    const int tok = i / 48, rem = i % 48, h = rem >> 3, c = rem & 7;
    const float l0 = p.lseA[(size_t)tok * 6 + h], l1 = p.lseA[((size_t)T_TOK + tok) * 6 + h], l2 = p.lseA[((size_t)2 * T_TOK + tok) * 6 + h];
    const float mx = fmaxf(l0, fmaxf(l1, l2));
    float w0 = __expf(l0 - mx), w1 = __expf(l1 - mx), w2 = __expf(l2 - mx);
    const float inv = 1.f / (w0 + w1 + w2);
    w0 *= inv; w1 *= inv; w2 *= inv;
    const size_t off = (size_t)tok * 384 + h * 64 + c * 8;
    const u32x4 a0 = *(const u32x4*)(p.oA + off), a1 = *(const u32x4*)(p.oA + (size_t)T_TOK * 384 + off), a2 = *(const u32x4*)(p.oA + (size_t)2 * T_TOK * 384 + off);
    u32x4 o;
#pragma unroll
    for (int e = 0; e < 4; ++e) {
      const float lo = w0 * bflo(a0[e]) + w1 * bflo(a1[e]) + w2 * bflo(a2[e]);
      const float hi = w0 * bfhi(a0[e]) + w1 * bfhi(a1[e]) + w2 * bfhi(a2[e]);
      o[e] = pack2(lo, hi);
    }
    *(u32x4*)(p.y + (size_t)tok * 1280 + h * 64 + c * 8) = o;
  }
  const float lam = p.lam[l * 2], sc0 = 1.f - p.lam[l * 2 + 1];
  const float* gs = p.g_subln + l * 128;
  const int totalB = T_TOK * 4 * 16;
  for (int i = blockIdx.x * NTHREADS + tid; i < totalB; i += gridDim.x * NTHREADS) {
    const int c = i & 15, th = i >> 4, h = th & 3, tok = th >> 2;
    const size_t off = (size_t)tok * 512 + h * 128 + c * 8;
    const u32x4 a1 = *(const u32x4*)(p.oB + off), a2 = *(const u32x4*)(p.oB + (size_t)T_TOK * 512 + off);
    float v[8]; float ss = 0.f;
#pragma unroll
    for (int e = 0; e < 4; ++e) {
      v[2 * e] = bflo(a1[e]) - lam * bflo(a2[e]); v[2 * e + 1] = bfhi(a1[e]) - lam * bfhi(a2[e]);
      ss += v[2 * e] * v[2 * e] + v[2 * e + 1] * v[2 * e + 1];
    }
    ss += __shfl_xor(ss, 1); ss += __shfl_xor(ss, 2); ss += __shfl_xor(ss, 4); ss += __shfl_xor(ss, 8);
    const float sc = rsqrtf(ss * (1.f / 128.f) + 1e-6f) * sc0;
    const f32x4 g0 = *(const f32x4*)(gs + c * 8), g1 = *(const f32x4*)(gs + c * 8 + 4);
    u32x4 o;
    o.x = pack2(v[0] * g0[0] * sc, v[1] * g0[1] * sc); o.y = pack2(v[2] * g0[2] * sc, v[3] * g0[3] * sc);
    o.z = pack2(v[4] * g1[0] * sc, v[5] * g1[1] * sc); o.w = pack2(v[6] * g1[2] * sc, v[7] * g1[3] * sc);
    *(u32x4*)(p.y + (size_t)tok * 1280 + 384 + h * 128 + c * 8) = o;
  }
}

__device__ __forceinline__ unsigned ord_bits(float x) { const unsigned u = __float_as_uint(x); return u ^ ((unsigned)((int)u >> 31) | 0x80000000u); }
__device__ __forceinline__ float unord_bits(unsigned k) { return __uint_as_float(k ^ ((k & 0x80000000u) ? 0x80000000u : 0xffffffffu)); }
__device__ __forceinline__ unsigned umax3(unsigned a, unsigned b, unsigned c) { return max(max(a, b), c); }

__device__ void phase_topk(const Params& p, int l, unsigned char* smem) {
  const int tid = opaque_tid(), lane = tid & 63, w = tid >> 6, fr = lane & 15, fq = lane >> 4;
  int* il = (int*)(smem + w * 2048);
  const bf16_t* sk = p.skeys + (size_t)l * 8 * 2 * 128 * 64;
  const int nunits = 1024 * 8, gw = gridDim.x * 4;
#pragma unroll 1
  for (int u = blockIdx.x * 4 + w; u < nunits; u += gw) {
    const int tok0 = (u >> 3) * 16, h = u & 7;
    unsigned key[2][32];
#pragma unroll
    for (int pp = 0; pp < 2; ++pp) {
      bf16x8 qf[2];
#pragma unroll
      for (int ks = 0; ks < 2; ++ks) qf[ks] = *(const bf16x8*)(p.pq + (size_t)(tok0 + fr) * 1024 + h * 128 + pp * 64 + ks * 32 + fq * 8);
#pragma unroll
      for (int kt = 0; kt < 8; ++kt) {
        const bf16_t* kp = sk + ((size_t)((h * 2 + pp) * 128 + kt * 16 + fr)) * 64 + fq * 8;
        f32x4 acc = mfma16(*(const bf16x8*)kp, qf[0], (f32x4){0.f, 0.f, 0.f, 0.f});
        acc = mfma16(*(const bf16x8*)(kp + 32), qf[1], acc);
#pragma unroll
        for (int r = 0; r < 4; ++r) key[pp][kt * 4 + r] = (ord_bits(acc[r]) & 0xffffff80u) | (unsigned)(127 - (kt * 16 + fq * 4 + r));
      }
    }
    float sval[2][16];
#pragma unroll
    for (int pp = 0; pp < 2; ++pp) {
#pragma unroll
      for (int r = 0; r < 16; ++r) {
        unsigned best = 0u;
#pragma unroll
        for (int i = 0; i < 32; i += 2) best = umax3(best, key[pp][i], key[pp][i + 1]);
        best = xswap32_max_u(xswap16_max_u(best));
#pragma unroll
        for (int i = 0; i < 32; ++i) key[pp][i] = (key[pp][i] == best) ? 0u : key[pp][i];
        sval[pp][r] = unord_bits(best & 0xffffff80u);
        if (fq == 0) il[(fr * 2 + pp) * 16 + r] = 127 - (int)(best & 127u);
      }
    }
    unsigned ck[21];
    {
      int sl = 0;
#pragma unroll
      for (int gi = 0; gi < 4; ++gi) {
        const float a = fq == 0 ? sval[0][4 * gi] : (fq == 1 ? sval[0][4 * gi + 1] : (fq == 2 ? sval[0][4 * gi + 2] : sval[0][4 * gi + 3]));
        const int irow = fq + 4 * gi;
        const int nj = gi == 0 ? 16 : (gi == 1 ? 3 : 1);
#pragma unroll
        for (int j = 0; j < nj; ++j) {
          const bool valid = (irow + 1) * (j + 1) <= 16;
          const unsigned k2 = (ord_bits(a + sval[1][j]) & 0xffffff00u) | (unsigned)(255 - (irow * 16 + j));
          ck[sl++] = valid ? k2 : 0u;
        }
      }
    }
    float bs[16]; int be[16];
#pragma unroll
    for (int r = 0; r < 16; ++r) {
      unsigned best = 0u;
#pragma unroll
      for (int i = 0; i < 20; i += 2) best = umax3(best, ck[i], ck[i + 1]);
      best = max(best, ck[20]);
      best = xswap32_max_u(xswap16_max_u(best));
#pragma unroll
      for (int i = 0; i < 21; ++i) ck[i] = (ck[i] == best) ? 0u : ck[i];
      const int c = 255 - (int)(best & 255u);
      bs[r] = unord_bits(best & 0xffffff00u);
      be[r] = il[(fr * 2 + 0) * 16 + (c >> 4)] * 128 + il[(fr * 2 + 1) * 16 + (c & 15)];
    }
    if (fq == 0) {
      float e[16]; float tot = 0.f;
#pragma unroll
      for (int r = 0; r < 16; ++r) { e[r] = __expf(bs[r] - bs[0]); tot += e[r]; }
      const float inv = 1.f / tot;
      const size_t ob = ((size_t)(tok0 + fr) * 8 + h) * 16;
#pragma unroll
      for (int c4 = 0; c4 < 4; ++c4) {
        *(f32x4*)(p.pgate + ob + c4 * 4) = (f32x4){e[c4 * 4] * inv, e[c4 * 4 + 1] * inv, e[c4 * 4 + 2] * inv, e[c4 * 4 + 3] * inv};
        *(int4*)(p.pidx + ob + c4 * 4) = make_int4(be[c4 * 4], be[c4 * 4 + 1], be[c4 * 4 + 2], be[c4 * 4 + 3]);
      }
    }
  }
}

__device__ __forceinline__ float gelu_exact(float x) { return 0.5f * x * (1.f + erff(x * 0.70710678118654752f)); }

typedef float f32x2 __attribute__((ext_vector_type(2)));
__device__ void phase_experts(const Params& p, int l) {
  const int tid = opaque_tid(), lane = tid & 63, w = tid >> 6;
  const unsigned char* U = p.pu8 + (size_t)l * 16384 * 1024;
  const float* gf = p.g_ffn + l * 1024;
  const int tstep = gridDim.x * 4;
  int tok = blockIdx.x * 4 + w;
  if (tok >= T_TOK) return;
  u32x4 rbuf[2][16];
  f32x4 xr[4];
  int id0 = p.pidx[(size_t)tok * 128 + lane], id1 = p.pidx[(size_t)tok * 128 + 64 + lane];
#pragma unroll
  for (int c = 0; c < 4; ++c) xr[c] = *(const f32x4*)(p.xcur + (size_t)tok * 1024 + lane * 16 + c * 4);
#pragma unroll
  for (int j = 0; j < 16; ++j) {
    const int row = __builtin_amdgcn_readlane(id0, j);
    rbuf[0][j] = *(const u32x4*)(U + (size_t)row * 1024 + lane * 16);
  }
#pragma unroll 1
  for (; tok < T_TOK; tok += tstep) {
    const int tokn = min(tok + tstep, T_TOK - 1);
    const int idn0 = p.pidx[(size_t)tokn * 128 + lane], idn1 = p.pidx[(size_t)tokn * 128 + 64 + lane];
    f32x4 xn[4];
#pragma unroll
    for (int c = 0; c < 4; ++c) xn[c] = *(const f32x4*)(p.xcur + (size_t)tokn * 1024 + lane * 16 + c * 4);
    const float g0 = p.pgate[(size_t)tok * 128 + lane], g1 = p.pgate[(size_t)tok * 128 + 64 + lane];
    float hv[16];
    float ss = 0.f;
#pragma unroll
    for (int c = 0; c < 4; ++c)
#pragma unroll
      for (int e = 0; e < 4; ++e) ss += xr[c][e] * xr[c][e];
    ss = wave_sum(ss);
    const float rstd = rsqrtf(ss * (1.f / 1024.f) + 1e-6f);
#pragma unroll
    for (int c = 0; c < 4; ++c) {
      const f32x4 g = *(const f32x4*)(gf + lane * 16 + c * 4);
#pragma unroll
      for (int e = 0; e < 4; ++e) hv[c * 4 + e] = xr[c][e] * rstd * g[e];
    }
    float d0 = 0.f, d1 = 0.f;
#pragma unroll
    for (int bi = 0; bi < 8; ++bi) {
      {
        const int nb = (bi + 1) & 7;
        const int idv = bi == 7 ? idn0 : (nb < 4 ? id0 : id1);
#pragma unroll
        for (int j = 0; j < 16; ++j) {
          const int row = __builtin_amdgcn_readlane(idv, (nb & 3) * 16 + j);
          rbuf[(bi + 1) & 1][j] = *(const u32x4*)(U + (size_t)row * 1024 + lane * 16);
        }
      }
      u32x4 (&ru)[16] = rbuf[bi & 1];
      float sj[16];
#pragma unroll
      for (int j = 0; j < 16; ++j) {
        float acc = 0.f;
#pragma unroll
        for (int c = 0; c < 4; ++c) {
          const f32x2 a = __builtin_amdgcn_cvt_pk_f32_fp8((int)ru[j][c], false), b2 = __builtin_amdgcn_cvt_pk_f32_fp8((int)ru[j][c], true);
          acc += a.x * hv[c * 4] + a.y * hv[c * 4 + 1] + b2.x * hv[c * 4 + 2] + b2.y * hv[c * 4 + 3];
        }
        sj[j] = acc;
      }
#pragma unroll
      for (int hw = 8; hw >= 1; hw >>= 1) {
        const bool up = (lane & hw) != 0;
#pragma unroll
        for (int k = 0; k < hw; ++k) {
          const float send = up ? sj[k] : sj[k + hw], keep = up ? sj[k + hw] : sj[k];
          sj[k] = keep + __shfl_xor(send, hw);
        }
      }
      float tot = sj[0];
      tot = xsum_rows(tot);
      if ((lane >> 4) == (bi & 3)) { if (bi < 4) d0 = tot; else d1 = tot; }
    }
    const float w0 = gelu_exact(d0 * (1.f / 256.f)) * g0 * (1.f / 64.f), w1 = gelu_exact(d1 * (1.f / 256.f)) * g1 * (1.f / 64.f);
    p.pw[(size_t)tok * 128 + lane] = w0;
    p.pw[(size_t)tok * 128 + 64 + lane] = w1;
    id0 = idn0; id1 = idn1;
#pragma unroll
    for (int c = 0; c < 4; ++c) xr[c] = xn[c];
  }
}

__device__ void phase_experts_v(const Params& p, int l) {
  const int tid = opaque_tid(), lane = tid & 63, w = tid >> 6;
  const int x = blockIdx.x & 7, slot = (blockIdx.x >> 3) * 4 + w, nslot = (gridDim.x >> 3) * 4;
  const int e8 = lane >> 3, c = lane & 7;
  const unsigned char* Vb = p.pv8 + (size_t)l * 16384 * 1024 + x * 128;
  const bool last = (l == NLAYER - 1);
  const int colb = x * 128 + c * 16 + ((lane & 32) ? 8 : 0) + ((lane & 16) ? 4 : 0) + ((lane & 8) ? 2 : 0);
  int rows[16]; float wt[16];
#pragma unroll
  for (int j = 0; j < 16; ++j) { rows[j] = p.pidx[(unsigned)(slot * 128 + e8) + 8 * j]; wt[j] = p.pw[(unsigned)(slot * 128 + e8) + 8 * j]; }
#pragma unroll 1
  for (int tok = slot; tok < T_TOK; tok += nslot) {
    const f32x2 xin = *(const f32x2*)(p.xcur + (unsigned)(tok * 1024 + colb));
    u32x4 rv[16];
#pragma unroll
    for (int j = 0; j < 16; ++j) rv[j] = *(const u32x4*)(Vb + (unsigned)(rows[j] * 1024 + c * 16));
    const int tokn = min(tok + nslot, T_TOK - 1);
    int rown[16]; float wtc[16];
#pragma unroll
    for (int j = 0; j < 16; ++j) { wtc[j] = wt[j]; rown[j] = p.pidx[(unsigned)(tokn * 128 + e8) + 8 * j]; wt[j] = p.pw[(unsigned)(tokn * 128 + e8) + 8 * j]; }
    float acc[16];
#pragma unroll
    for (int i = 0; i < 16; ++i) acc[i] = 0.f;
#pragma unroll
    for (int j = 0; j < 16; ++j)
#pragma unroll
      for (int q = 0; q < 4; ++q) {
        const f32x2 a = __builtin_amdgcn_cvt_pk_f32_fp8((int)rv[j][q], false), b2 = __builtin_amdgcn_cvt_pk_f32_fp8((int)rv[j][q], true);
        acc[q * 4] += wtc[j] * a.x; acc[q * 4 + 1] += wtc[j] * a.y; acc[q * 4 + 2] += wtc[j] * b2.x; acc[q * 4 + 3] += wtc[j] * b2.y;
      }
#pragma unroll
    for (int j = 0; j < 16; ++j) rows[j] = rown[j];
#pragma unroll
    for (int hw = 8; hw >= 2; hw >>= 1) {
      const int msk = hw * 4;
      const bool up = (lane & msk) != 0;
#pragma unroll
      for (int k = 0; k < hw; ++k) {
        const float send = up ? acc[k] : acc[k + hw], keep = up ? acc[k + hw] : acc[k];
        acc[k] = keep + __shfl_xor(send, msk);
      }
    }
    const float x0 = xin[0] + acc[0], x1 = xin[1] + acc[1];
    *(f32x2*)(p.xcur + (unsigned)(tok * 1024 + colb)) = (f32x2){x0, x1};
    if (!last) *(unsigned*)(p.xb + (unsigned)(tok * 1024 + colb)) = pack2(x0, x1);
    const float ss = wave_sum(x0 * x0 + x1 * x1);
    if (lane == 0) p.ssqn[tok * 8 + x] = ss;
  }
}

__device__ void phase_final(const Params& p) {
  const int tid = opaque_tid(), lane = tid & 63, w = tid >> 6;
  for (int tok = blockIdx.x * 4 + w; tok < T_TOK; tok += gridDim.x * 4) {
    const f32x4 s0 = *(const f32x4*)(p.ssqn + tok * 8), s1 = *(const f32x4*)(p.ssqn + tok * 8 + 4);
    const float rn = rsqrtf(((s0[0] + s0[1]) + (s0[2] + s0[3]) + (s1[0] + s1[1]) + (s1[2] + s1[3])) * (1.f / 1024.f) + 1e-6f);
#pragma unroll
    for (int q = 0; q < 4; ++q) {
      const f32x4 v = *(const f32x4*)(p.xcur + (size_t)tok * 1024 + q * 256 + lane * 4);
      const f32x4 g = *(const f32x4*)(p.g_final + q * 256 + lane * 4);
      *(f32x4*)(p.out + (size_t)tok * 1024 + q * 256 + lane * 4) = v * g * rn;
    }
  }
}

__device__ int t5_bucket(int n) {
  if (n < 16) return n;
  int v = 16 + (int)(log((double)n / 16.0) / log(128.0) * 16.0);
  return v > 31 ? 31 : v;
}

__device__ void phase_prologue(const Params& p, unsigned char* smem) {
  const int tid = opaque_tid(), lane = tid & 63, w = tid >> 6;
  const int gtid = blockIdx.x * NTHREADS + tid, gsz = gridDim.x * NTHREADS;
  {
    bf16_t* tl = (bf16_t*)smem;
    const int nq = tid & 15, kr = tid >> 4;
    f32x4 v[4]; float gk[4];
    int cji = 0, ckt = 0, cnt = 0;
    auto find = [&](int t, int& ji, int& kt, int& nt) {
      ji = 0;
      while (ji + 1 < p.njobs && p.jobs[ji + 1].tile0 <= t) ++ji;
      const int lt = t - p.jobs[ji].tile0;
      kt = lt / p.jobs[ji].ntn; nt = lt % p.jobs[ji].ntn;
    };
    auto issue = [&](int ji, int kt, int nt) {
      const TrJob& jb = p.jobs[ji];
      const int n = nt * 64 + nq * 4;
#pragma unroll
      for (int ps = 0; ps < 4; ++ps) {
        const int k = kt * 64 + ps * 16 + kr;
        v[ps] = (n < jb.N) ? *(const f32x4*)(jb.src + (size_t)k * jb.lds + n) : (f32x4){0.f, 0.f, 0.f, 0.f};
        gk[ps] = jb.g ? jb.g[k] : 1.f;
      }
    };
    int t = blockIdx.x;
    if (t < p.total_tr_tiles) { find(t, cji, ckt, cnt); issue(cji, ckt, cnt); }
    for (; t < p.total_tr_tiles; t += gridDim.x) {
      __syncthreads();
#pragma unroll
      for (int ps = 0; ps < 4; ++ps)
#pragma unroll
        for (int e = 0; e < 4; ++e) tl[(nq * 4 + e) * 66 + ps * 16 + kr] = (bf16_t)(pack2(v[ps][e] * gk[ps], 0.f) & 0xffffu);
      const int oji = cji, okt = ckt, ont = cnt;
      const int tn = t + gridDim.x;
      if (tn < p.total_tr_tiles) { find(tn, cji, ckt, cnt); issue(cji, ckt, cnt); }
      __syncthreads();
      const TrJob& jo = p.jobs[oji];
#pragma unroll
      for (int hh = 0; hh < 2; ++hh) {
        const int ci = tid + hh * NTHREADS, nn = ci >> 3, kc = ci & 7;
        const int n = ont * 64 + nn;
        const unsigned* lp = (const unsigned*)(tl + nn * 66 + kc * 8);
        const u32x4 o = (u32x4){lp[0], lp[1], lp[2], lp[3]};
        if (n < jo.N) *(u32x4*)(jo.dst + (size_t)n * jo.ldd + okt * 64 + kc * 8) = o;
      }
    }
  }
  {
    const size_t k8 = (size_t)NLAYER * 8 * 2 * 128 * 64 / 8;
    for (size_t i = gtid; i < k8; i += gsz) {
      const f32x4 a = *(const f32x4*)(p.sub_keys + i * 8), b = *(const f32x4*)(p.sub_keys + i * 8 + 4);
      *(u32x4*)(p.skeys + i * 8) = (u32x4){pack2(a[0], a[1]), pack2(a[2], a[3]), pack2(b[0], b[1]), pack2(b[2], b[3])};
    }
  }
  for (int i = gtid; i < NLAYER * 96 * 1024 / 2; i += gsz) { const int l = i / (96 * 512), r = i % (96 * 512); ((unsigned*)(p.Wt_in + ((size_t)l * INC + 6176) * 1024))[r] = 0u; }
  for (int i = gtid; i < NLAYER * 64 * 256 / 2; i += gsz) { const int l = i / (64 * 128), r = i % (64 * 128); ((unsigned*)(p.Wt_uq + ((size_t)l * 640 + 576) * 256))[r] = 0u; }
  for (int i = gtid; i < 3 * 6 * 129; i += gsz) {
    const int g = i / (6 * 129), h = (i / 129) % 6, rel = i % 129;
    const int d = g == 0 ? 1 : (g == 1 ? 4 : 16);
    p.biasA2[i] = p.rel_bias[t5_bucket(rel * d) * 10 + h] * LOG2E;
  }
  for (int i = gtid; i < 4 * 2048; i += gsz) {
    const int h = i >> 11, dist = i & 2047, bk = t5_bucket(dist);
    p.biasB2[i] = __uint_as_float((__float_as_uint(p.rel_bias[bk * 10 + 6 + h] * LOG2E) & ~31u) | (unsigned)bk);
  }
  for (int i = gtid; i < SEQ * 16; i += gsz) {
    const int pos = i >> 4, j = i & 15;
    const float inv = powf(10000.f, -(float)j / 16.f);
    const float ang = (float)pos * inv;
    p.ropec[i] = (float)cos((double)ang); p.ropes[i] = (float)sin((double)ang);
  }
  if (blockIdx.x == 0 && w < NLAYER) {
    const int l = w;
    float a = wave_sum(p.lam_q1[l * 64 + lane] * p.lam_k1[l * 64 + lane]);
    float b = wave_sum(p.lam_q2[l * 64 + lane] * p.lam_k2[l * 64 + lane]);
    const float li = 0.8f - 0.6f * expf(-0.3f * (float)l);
    if (lane == 0) { p.lam[l * 2] = expf(a) - expf(b) + li; p.lam[l * 2 + 1] = li; for (int c = 0; c < 48; ++c) p.counters[c * 4 + l] = 0; }
  }
  for (int tok = blockIdx.x * 4 + w; tok < T_TOK; tok += gridDim.x * 4) {
    f32x4 v[4]; float ss = 0.f;
#pragma unroll
    for (int q = 0; q < 4; ++q) { v[q] = *(const f32x4*)(p.x + (size_t)tok * 1024 + q * 256 + lane * 4); ss += v[q][0] * v[q][0] + v[q][1] * v[q][1] + v[q][2] * v[q][2] + v[q][3] * v[q][3]; }
    ss = wave_sum(ss);
    if (lane < 8) p.ssqn[tok * 8 + lane] = lane == 0 ? ss : 0.f;
#pragma unroll
    for (int q = 0; q < 4; ++q) {
      store4bf(p.xb + (size_t)tok * 1024 + q * 256 + lane * 4, v[q]);
    }
  }
}

#define XB_TMO      128
#define XB_XCNT(j)  (256  + 64 * (j))
#define XB_XSUB(j)  (1280 + 64 * (j))
#define XB_XGEN(j)  (2304 + 64 * (j))
#define XB_TOP      3328
#define XB_TOPGEN   3392
#define XCD_BAR_WORDS 3456
#define XB_SPIN_CAP (1u << 20)
__device__ __forceinline__ unsigned xb_ld(unsigned* p)              { return __hip_atomic_load(p, __ATOMIC_RELAXED, __HIP_MEMORY_SCOPE_AGENT); }
__device__ __forceinline__ unsigned xb_add(unsigned* p, unsigned v) { return __hip_atomic_fetch_add(p, v, __ATOMIC_RELAXED, __HIP_MEMORY_SCOPE_AGENT); }
__device__ __forceinline__ unsigned xb_xcc_id() { return (unsigned)__builtin_amdgcn_s_getreg((3 << 11) | 20) & 0xFu; }
#define XB_SPIN(cond, bar) do { unsigned _sp = 0; while (cond) { __builtin_amdgcn_s_sleep(1); \
    if ((++_sp & 255u) == 0u) { if (xb_ld(&(bar)[XB_TMO])) break; if (_sp > XB_SPIN_CAP) { atomicAdd(&(bar)[XB_TMO], 1u); break; } } } } while (0)
struct XcdBarrier { unsigned* bar; unsigned x; volatile unsigned* st; };
__device__ __forceinline__ XcdBarrier xcd_barrier_post(unsigned* bar, volatile unsigned* st) {
  XcdBarrier b; b.bar = bar; b.x = xb_xcc_id(); b.st = st;
  if (threadIdx.x == 0) (void)xb_add(&bar[XB_XCNT(b.x)], 1u);
  return b;
}
__device__ __forceinline__ void xcd_barrier_complete(unsigned* bar, unsigned x, unsigned& nloc, unsigned& nx) {
  const unsigned G = gridDim.x;
  unsigned sum, cnt, mine, sp = 0u;
  for (;;) {
    sum = 0u; cnt = 0u; mine = 0u;
#pragma unroll
    for (unsigned j = 0; j < 16; ++j) { const unsigned c = xb_ld(&bar[XB_XCNT(j)]); sum += c; cnt += (c > 0u) ? 1u : 0u; mine = (j == x) ? c : mine; }
    if (sum == G) break;
    __builtin_amdgcn_s_sleep(1);
    if ((++sp & 255u) == 0u) { if (xb_ld(&bar[XB_TMO])) break; if (sp > XB_SPIN_CAP) { atomicAdd(&bar[XB_TMO], 1u); break; } }
  }
  nloc = mine > 0u ? mine : 1u; nx = cnt > 0u ? cnt : 1u;
}
__device__ __forceinline__ void xcd_barrier(const XcdBarrier& b0) {
  asm volatile("s_waitcnt vmcnt(0)" ::: "memory");
  __syncthreads();
  if (threadIdx.x == 0) {
    XcdBarrier b; b.x = xb_xcc_id();
    { unsigned* t = b0.bar; asm volatile("" : "+s"(t)); b.bar = t; }
    { volatile unsigned* t = b0.st; asm volatile("" : "+s"(t)); b.st = t; }
    unsigned* bar = b.bar;
    __builtin_amdgcn_s_waitcnt(0);
    unsigned nloc = b.st[0], nx = b.st[1];
    if (nloc == 0u) { xcd_barrier_complete(bar, b.x, nloc, nx); b.st[0] = nloc; b.st[1] = nx; }
    const unsigned old = xb_add(&bar[XB_XSUB(b.x)], 1u);
    const unsigned gen = old / nloc;
    if (old + 1u == (gen + 1u) * nloc) {
      __builtin_amdgcn_fence(__ATOMIC_RELEASE, "agent");
      asm volatile("s_waitcnt vmcnt(0)" ::: "memory");
      const unsigned og = xb_add(&bar[XB_TOP], 1u);
      const unsigned tg = og / nx;
      if (og + 1u == (tg + 1u) * nx) xb_add(&bar[XB_TOPGEN], 1u);
      else XB_SPIN(xb_ld(&bar[XB_TOPGEN]) == tg, bar);
      __builtin_amdgcn_fence(__ATOMIC_ACQUIRE, "agent");
      xb_add(&bar[XB_XGEN(b.x)], 1u);
      asm volatile("s_waitcnt vmcnt(0)" ::: "memory");
    } else {
      XB_SPIN(xb_ld(&bar[XB_XGEN(b.x)]) == gen, bar);
      __builtin_amdgcn_fence(__ATOMIC_ACQUIRE, "agent");
      asm volatile("s_waitcnt vmcnt(0)" ::: "memory");
    }
  }
  __syncthreads();
}

extern "C" __global__ void __launch_bounds__(NTHREADS, 2) mega(Params p) {
  cg::grid_group grid = cg::this_grid();
  extern __shared__ __attribute__((aligned(16))) unsigned char smem[];
  volatile unsigned* st = (volatile unsigned*)(smem + SMEM_BYTES - 16);
  if (threadIdx.x < 2) st[threadIdx.x] = 0u;
  __syncthreads();
  const XcdBarrier xb = xcd_barrier_post(p.bar, st);
  phase_prologue(p, smem);
  if (p.njobs < 0) grid.sync();
  xcd_barrier(xb);
#ifdef PROBE_SYNC
  for (int i = 0; i < 100; ++i) xcd_barrier(xb);
#endif
#pragma unroll 1
  for (int l = 0; l < NLAYER; ++l) {
    phase_inproj(p, l, smem);
    xcd_barrier(xb);
    phase_cup(p, l, smem);
    xcd_barrier(xb);
    phase_attn(p, l, smem);
    xcd_barrier(xb);
    phase_mergeA(p, l);
    xcd_barrier(xb);
    phase_branch(p, l, smem);
    xcd_barrier(xb);
    phase_wout(p, l, smem);
    xcd_barrier(xb);
    phase_pq(p, l, smem);
    xcd_barrier(xb);
    phase_topk(p, l, smem);
    xcd_barrier(xb);
    phase_experts(p, l);
    xcd_barrier(xb);
    phase_experts_v(p, l);
    xcd_barrier(xb);
  }
  phase_final(p);
}

extern "C" void kernel_launch(void* const* d_in, const int* in_sizes, int n_in, void* d_out, int out_size, void* d_ws, size_t ws_size,
                              hipStream_t stream) {
  (void)in_sizes; (void)n_in; (void)out_size;
  constexpr size_t kDynLds = SMEM_BYTES;
  static int grid_blocks = 0;
  if (!grid_blocks) {
    int dev = 0, cus = 0, per_cu = 0;
    (void)hipGetDevice(&dev);
    (void)hipDeviceGetAttribute(&cus, hipDeviceAttributeMultiprocessorCount, dev);
    (void)hipFuncSetAttribute((const void*)mega, hipFuncAttributeMaxDynamicSharedMemorySize, (int)kDynLds);
    (void)hipOccupancyMaxActiveBlocksPerMultiprocessor(&per_cu, mega, NTHREADS, kDynLds);
    if (per_cu > 2) per_cu = 2;
    if (per_cu < 1) per_cu = 1;
    grid_blocks = cus * per_cu;
    grid_blocks -= grid_blocks % 8;
  }
  const float* const* in = (const float* const*)d_in;
  Params p;
  memset(&p, 0, sizeof(p));
  p.x = in[0]; p.rel_bias = in[1]; p.lam_q1 = in[8]; p.lam_k1 = in[9]; p.lam_q2 = in[10]; p.lam_k2 = in[11]; p.g_subln = in[12];
  p.peer_u = in[20]; p.peer_v = in[21]; p.sub_keys = in[19]; p.g_final = in[22]; p.g_ffn = in[17];
  p.out = (float*)d_out;
  size_t off = 0;
  auto alloc = [&](size_t bytes) { void* r = (char*)d_ws + off; off += (bytes + 255) & ~(size_t)255; return r; };
  const size_t T = T_TOK;
  p.xcur = (float*)alloc(T * 1024 * 4); p.xb = (bf16_t*)alloc(T * 1024 * 2); p.qkvA = (bf16_t*)alloc(T * 1152 * 2); p.qkB = (bf16_t*)alloc(T * 1024 * 2);
  p.vtB = (bf16_t*)alloc(T * 512 * 2); p.cq_lat = (bf16_t*)alloc(T * 256 * 2); p.ckv_lat = (bf16_t*)alloc(T * 128 * 2);
  p.ssq_cq = (float*)alloc(T * 4 * 4); p.ssq_ckv = (float*)alloc(T * 2 * 4); p.gates = (bf16_t*)alloc(T * 3072 * 2); p.cq = (bf16_t*)alloc(T * 576 * 2);
  p.kC = (bf16_t*)alloc(T * 576 * 2); p.vtC = (bf16_t*)alloc(T * 384 * 2); p.oA = (bf16_t*)alloc(3 * T * 384 * 2); p.lseA = (float*)alloc(3 * T * 6 * 4); p.oB = (bf16_t*)alloc(2 * T * 512 * 2);
  p.y = (bf16_t*)alloc(T * 1280 * 2); p.mix = (bf16_t*)alloc(T * 1024 * 2); p.ssq2 = (float*)alloc(T * 16 * 4); p.pq = (bf16_t*)alloc(T * 1024 * 2);
  p.pidx = (int*)alloc(T * 128 * 4); p.pgate = (float*)alloc(T * 128 * 4); p.pw = (float*)alloc(T * 128 * 4); p.ssqn = (float*)alloc(T * 8 * 4);
  p.Wt_in = (bf16_t*)alloc((size_t)NLAYER * INC * 1024 * 2); p.Wt_uq = (bf16_t*)alloc((size_t)NLAYER * 640 * 256 * 2); p.Wt_ukv = (bf16_t*)alloc((size_t)NLAYER * 768 * 128 * 2);
  p.Wt_br = (bf16_t*)alloc((size_t)NLAYER * 1024 * 1280 * 2); p.Wt_out = (bf16_t*)alloc((size_t)NLAYER * 1024 * 1024 * 2); p.Wt_pq = (bf16_t*)alloc((size_t)NLAYER * 1024 * 1024 * 2);
  p.skeys = (bf16_t*)alloc((size_t)NLAYER * 8 * 2 * 128 * 64 * 2); p.pu8 = (unsigned char*)alloc((size_t)NLAYER * 16384 * 1024); p.pv8 = (unsigned char*)alloc((size_t)NLAYER * 16384 * 1024);
  p.biasA2 = (float*)alloc(3 * 6 * 129 * 4); p.biasB2 = (float*)alloc(4 * 2048 * 4); p.ropec = (float*)alloc(SEQ * 16 * 4); p.ropes = (float*)alloc(SEQ * 16 * 4);
  p.lam = (float*)alloc(64); p.counters = (int*)alloc(1024); p.bar = (unsigned*)alloc(XCD_BAR_WORDS * 4);
  if (off > ws_size) fprintf(stderr, "workspace too small: need %zu have %zu\n", off, ws_size);
  int nj = 0, tiles = 0;
  auto job = [&](const float* src, const float* g, bf16_t* dst, int K, int N, int lds, int ldd) {
    TrJob& j = p.jobs[nj++]; j.src = src; j.g = g; j.dst = dst; j.K = K; j.N = N; j.lds = lds; j.ldd = ldd; j.tile0 = tiles; j.ntn = (N + 63) / 64;
    tiles += (K / 64) * j.ntn;
  };
  for (int l = 0; l < NLAYER; ++l) {
    const float* win = in[2] + (size_t)l * 1024 * 6176; const float* gm = in[3] + l * 1024;
    bf16_t* wt = p.Wt_in + (size_t)l * INC * 1024;
    job(win, gm, wt, 1024, 3072, 6176, 1024);
    job(win + 3104, gm, wt + (size_t)3072 * 1024, 1024, 3072, 6176, 1024);
    job(win + 3072, gm, wt + (size_t)6144 * 1024, 1024, 32, 6176, 1024);
    job(in[4] + (size_t)l * 256 * 576, in[5] + l * 256, p.Wt_uq + (size_t)l * 640 * 256, 256, 576, 576, 256);
    job(in[6] + (size_t)l * 128 * 768, in[7] + l * 128, p.Wt_ukv + (size_t)l * 768 * 128, 128, 768, 768, 128);
    bf16_t* wb = p.Wt_br + (size_t)l * 1024 * 1280;
    job(in[13] + (size_t)l * 384 * 1024, nullptr, wb, 384, 1024, 1024, 1280);
    job(in[14] + (size_t)l * 512 * 1024, nullptr, wb + 384, 512, 1024, 1024, 1280);
    job(in[15] + (size_t)l * 384 * 1024, nullptr, wb + 896, 384, 1024, 1024, 1280);
    job(in[16] + (size_t)l * 1024 * 1024, nullptr, p.Wt_out + (size_t)l * 1024 * 1024, 1024, 1024, 1024, 1024);
    job(in[18] + (size_t)l * 1024 * 1024, in[17] + l * 1024, p.Wt_pq + (size_t)l * 1024 * 1024, 1024, 1024, 1024, 1024);
  }
  p.njobs = nj; p.total_tr_tiles = tiles;
  (void)hipMemsetAsync(p.bar, 0, XCD_BAR_WORDS * 4, stream);
  void* args[] = {&p};
  hipError_t e = hipLaunchCooperativeKernel((void*)mega, dim3(grid_blocks), dim3(NTHREADS), args, kDynLds, stream);
  if (e != hipSuccess) fprintf(stderr, "cooperative launch failed: %s (grid %d)\n", hipGetErrorString(e), grid_blocks);
}
```
